# Optimizing an MI355X kernel written in HIP

```python
import math
import jax, jax.numpy as jnp
from jax import lax
import numpy as np

D_MODEL = 1024
BATCH = 8
SEQ = 4096
DEPTH = 1

N_META = 16
BLOCK_Q = 128
EPS = 1e-6
NEG_INF = -1e30

SSM_WIDTH = D_MODEL // 2
SSM_GROUP = 16
SSM_GROUPS = SSM_WIDTH // SSM_GROUP
SSM_STATE = 64
DT_MIN = 1e-3
DT_MAX = 1e-1

ATT_HEADS = 4
QK_DIM = 64
V_DIM = 2 * QK_DIM
ATT_WIDTH = ATT_HEADS * V_DIM
QK_COLS = ATT_HEADS * 2 * QK_DIM

IN_COLS = SSM_WIDTH + 2 * QK_COLS + ATT_WIDTH + 2 * D_MODEL
SPLITS = (SSM_WIDTH,
          SSM_WIDTH + QK_COLS,
          SSM_WIDTH + 2 * QK_COLS,
          SSM_WIDTH + 2 * QK_COLS + ATT_WIDTH,
          SSM_WIDTH + 2 * QK_COLS + ATT_WIDTH + D_MODEL)

D_FF = ((8 * D_MODEL // 3 + 127) // 128) * 128
CONV_W = 3

kernel_name = 'hybrid_s5_diffattn_convffn_block'


def rmsnorm(x, g):
    xf = x.astype(jnp.float32)
    r = lax.rsqrt(jnp.mean(xf * xf, axis=-1, keepdims=True) + EPS)
    return (xf * r).astype(x.dtype) * g


def s5_mixer(u, a_re, a_im, log_dt, b_re, b_im, c_re, c_im, d, glu_w, glu_b):
    bsz, seq_len, _ = u.shape
    ug = u.astype(jnp.float32).reshape(bsz, seq_len, SSM_GROUPS, SSM_GROUP)
    a_re = a_re.astype(jnp.float32); a_im = a_im.astype(jnp.float32)
    dt = jnp.exp(log_dt.astype(jnp.float32))[:, None]
    mag = jnp.exp(a_re * dt)
    lb_re = mag * jnp.cos(a_im * dt)
    lb_im = mag * jnp.sin(a_im * dt)
    den = a_re * a_re + a_im * a_im
    n_re = lb_re - 1.0
    f_re = (n_re * a_re + lb_im * a_im) / den
    f_im = (lb_im * a_re - n_re * a_im) / den
    b_re = b_re.astype(jnp.float32); b_im = b_im.astype(jnp.float32)
    bb_re = f_re[..., None] * b_re - f_im[..., None] * b_im
    bb_im = f_re[..., None] * b_im + f_im[..., None] * b_re
    x_re = jnp.einsum('blgc,gpc->blgp', ug, bb_re)
    x_im = jnp.einsum('blgc,gpc->blgp', ug, bb_im)
    shp = (1, seq_len, SSM_GROUPS, SSM_STATE)
    a_re_t = jnp.broadcast_to(lb_re, shp)
    a_im_t = jnp.broadcast_to(lb_im, shp)

    def combine(left, right):
        ar_l, ai_l, br_l, bi_l = left
        ar_r, ai_r, br_r, bi_r = right
        return (ar_r * ar_l - ai_r * ai_l,
                ar_r * ai_l + ai_r * ar_l,
                ar_r * br_l - ai_r * bi_l + br_r,
                ar_r * bi_l + ai_r * br_l + bi_r)

    _, _, s_re, s_im = lax.associative_scan(combine, (a_re_t, a_im_t, x_re, x_im), axis=1)
    y = (jnp.einsum('blgp,gcp->blgc', s_re, c_re.astype(jnp.float32))
         - jnp.einsum('blgp,gcp->blgc', s_im, c_im.astype(jnp.float32))
         + d.astype(jnp.float32) * ug)
    y = jax.nn.gelu(y.reshape(bsz, seq_len, SSM_WIDTH)).astype(u.dtype)
    return y * jax.nn.sigmoid(y @ glu_w + glu_b)


def diff_attention(q, k, v, lam, slopes):
    bsz, seq_len = q.shape[:2]
    nb = seq_len // BLOCK_Q
    qb = jnp.moveaxis(q.reshape(bsz, nb, BLOCK_Q, ATT_HEADS, 2, QK_DIM), 1, 0)
    starts = jnp.arange(nb, dtype=jnp.int32) * BLOCK_Q
    kpos = jnp.arange(seq_len, dtype=jnp.int32)

    def one_block(args):
        q_blk, start = args
        s = jnp.einsum('bqhjd,bkhjd->bhjqk', q_blk, k,
                       preferred_element_type=jnp.float32)
        dist = (start + jnp.arange(BLOCK_Q, dtype=jnp.int32))[:, None] - kpos[None, :]
        s = s - slopes[None, :, None, None, None] * dist.astype(jnp.float32)[None, None, None]
        s = jnp.where(dist[None, None, None] >= 0, s, NEG_INF)
        p = jax.nn.softmax(s, axis=-1)
        w = p[:, :, 0] - lam * p[:, :, 1]
        return jnp.einsum('bhqk,bkhe->bqhe', w.astype(v.dtype), v)

    o = lax.map(one_block, (qb, starts))
    return jnp.moveaxis(o, 0, 1).reshape(bsz, seq_len, ATT_HEADS, V_DIM)


def conv_glu_ffn(h, w_up, conv_w, conv_b, w_down):
    seq_len = h.shape[1]
    up = h @ w_up
    a, b = up[..., :D_FF], up[..., D_FF:]
    a_pad = jnp.pad(a, ((0, 0), (CONV_W - 1, 0), (0, 0)))
    c = (a_pad[:, 0:seq_len] * conv_w[0] + a_pad[:, 1:seq_len + 1] * conv_w[1]
         + a_pad[:, 2:seq_len + 2] * conv_w[2] + conv_b)
    return (jax.nn.gelu(c) * b) @ w_down


def setup_inputs(seed: int = 0) -> dict:
    key = jax.random.key(seed)
    ks = jax.random.split(key, 32)
    f32 = jnp.float32
    nrm = lambda k, shp, s: s * jax.random.normal(k, shp, f32)
    L_ = DEPTH
    return {
        'x': jax.random.normal(ks[0], (BATCH, SEQ, D_MODEL), f32),
        'meta_tokens': nrm(ks[1], (N_META, D_MODEL), 1.0),
        'norm1_g': 1.0 + nrm(ks[2], (L_, D_MODEL), 0.02),
        'w_in': nrm(ks[3], (L_, D_MODEL, IN_COLS), D_MODEL ** -0.5),
        'ssm_a_re': -0.5 + nrm(ks[4], (L_, SSM_GROUPS, SSM_STATE), 0.01),
        'ssm_a_im': math.pi * jnp.arange(SSM_STATE, dtype=f32)[None, None, :]
                    + nrm(ks[5], (L_, SSM_GROUPS, SSM_STATE), 0.01),
        'ssm_log_dt': jax.random.uniform(ks[6], (L_, SSM_GROUPS), f32,
                                         math.log(DT_MIN), math.log(DT_MAX)),
        'ssm_b_re': nrm(ks[7], (L_, SSM_GROUPS, SSM_STATE, SSM_GROUP), (2 * SSM_GROUP) ** -0.5),
        'ssm_b_im': nrm(ks[8], (L_, SSM_GROUPS, SSM_STATE, SSM_GROUP), (2 * SSM_GROUP) ** -0.5),
        'ssm_c_re': nrm(ks[9], (L_, SSM_GROUPS, SSM_GROUP, SSM_STATE), (2 * SSM_STATE) ** -0.5),
        'ssm_c_im': nrm(ks[10], (L_, SSM_GROUPS, SSM_GROUP, SSM_STATE), (2 * SSM_STATE) ** -0.5),
        'ssm_d': nrm(ks[11], (L_, SSM_GROUPS, SSM_GROUP), 1.0),
        'ssm_glu_w': nrm(ks[12], (L_, SSM_WIDTH, SSM_WIDTH), SSM_WIDTH ** -0.5),
        'ssm_glu_b': nrm(ks[13], (L_, SSM_WIDTH), 0.01),
        'q_norm_g': 1.0 + nrm(ks[14], (L_, QK_DIM), 0.02),
        'k_norm_g': 1.0 + nrm(ks[15], (L_, QK_DIM), 0.02),
        'lam_q1': nrm(ks[16], (L_, QK_DIM), 0.1),
        'lam_k1': nrm(ks[17], (L_, QK_DIM), 0.1),
        'lam_q2': nrm(ks[18], (L_, QK_DIM), 0.1),
        'lam_k2': nrm(ks[19], (L_, QK_DIM), 0.1),
        'subln_g': 1.0 + nrm(ks[20], (L_, V_DIM), 0.02),
        'w_ssm_out': nrm(ks[21], (L_, SSM_WIDTH, D_MODEL), SSM_WIDTH ** -0.5),
        'w_att_out': nrm(ks[22], (L_, ATT_WIDTH, D_MODEL), ATT_WIDTH ** -0.5),
        'w_o': nrm(ks[23], (L_, D_MODEL, D_MODEL), D_MODEL ** -0.5),
        'norm2_g': 1.0 + nrm(ks[24], (L_, D_MODEL), 0.02),
        'w_up': nrm(ks[25], (L_, D_MODEL, 2 * D_FF), D_MODEL ** -0.5),
        'conv_w': nrm(ks[26], (L_, CONV_W, D_FF), CONV_W ** -0.5),
        'conv_b': nrm(ks[27], (L_, D_FF), 0.01),
        'w_down': nrm(ks[28], (L_, D_FF, D_MODEL), D_FF ** -0.5),
    }


def reference(x, meta_tokens, norm1_g, w_in, ssm_a_re, ssm_a_im, ssm_log_dt, ssm_b_re, ssm_b_im,
              ssm_c_re, ssm_c_im, ssm_d, ssm_glu_w, ssm_glu_b, q_norm_g, k_norm_g,
              lam_q1, lam_k1, lam_q2, lam_k2, subln_g, w_ssm_out, w_att_out, w_o,
              norm2_g, w_up, conv_w, conv_b, w_down):
    bsz, seq, _ = x.shape
    seq_len = seq + N_META
    seq_pad = -(-seq_len // BLOCK_Q) * BLOCK_Q
    meta = jnp.broadcast_to(meta_tokens[None].astype(x.dtype), (bsz, N_META, D_MODEL))
    h = jnp.concatenate([meta, x, jnp.zeros((bsz, seq_pad - seq_len, D_MODEL), x.dtype)], axis=1)
    slopes = 2.0 ** (-8.0 * jnp.arange(1, ATT_HEADS + 1, dtype=jnp.float32) / ATT_HEADS)
    q_scale = QK_DIM ** -0.5

    for l in range(DEPTH):
        lam_init = 0.8 - 0.6 * math.exp(-0.3 * l)
        hn = rmsnorm(h, norm1_g[l])
        proj = hn @ w_in[l]
        u, q, k, v, g_ssm, g_att = jnp.split(proj, SPLITS, axis=-1)
        y_ssm = s5_mixer(u, ssm_a_re[l], ssm_a_im[l], ssm_log_dt[l], ssm_b_re[l], ssm_b_im[l],
                         ssm_c_re[l], ssm_c_im[l], ssm_d[l], ssm_glu_w[l], ssm_glu_b[l])
        q = rmsnorm(q.reshape(bsz, seq_pad, ATT_HEADS, 2, QK_DIM), q_norm_g[l]) * q_scale
        k = rmsnorm(k.reshape(bsz, seq_pad, ATT_HEADS, 2, QK_DIM), k_norm_g[l])
        v = v.reshape(bsz, seq_pad, ATT_HEADS, V_DIM)
        lam = (jnp.exp(jnp.sum(lam_q1[l] * lam_k1[l]).astype(jnp.float32))
               - jnp.exp(jnp.sum(lam_q2[l] * lam_k2[l]).astype(jnp.float32)) + lam_init)
        o = diff_attention(q, k, v, lam, slopes)
        y_att = (rmsnorm(o, subln_g[l]) * (1.0 - lam_init)).reshape(bsz, seq_pad, ATT_WIDTH)
        mixed = (jax.nn.sigmoid(g_ssm) * (y_ssm @ w_ssm_out[l])
                 + jax.nn.sigmoid(g_att) * (y_att @ w_att_out[l]))
        h = h + mixed @ w_o[l]
        h = h + conv_glu_ffn(rmsnorm(h, norm2_g[l]), w_up[l], conv_w[l], conv_b[l], w_down[l])

    return h[:, N_META:N_META + seq]
```

```cpp
#include <hip/hip_runtime.h>
#include <hip/hip_cooperative_groups.h>
#include <cstdio>
#include <cstdint>
namespace cg = cooperative_groups;

namespace pg8 {
#define PG8_LAS __attribute__((address_space(3)))
typedef unsigned short bf16_t;
typedef short bf16x8 __attribute__((ext_vector_type(8)));
typedef float f32x4 __attribute__((ext_vector_type(4)));
typedef unsigned u32x4 __attribute__((ext_vector_type(4)));
constexpr int BM = 256, BK = 64, HALF = 128, HTB = HALF * BK * 2  , STAGE_BYTES = 8 * HTB, NXCD = 8, WGM = 2;

__host__ __device__ __forceinline__ int lds_byte(int r, int c) { const int st = (r >> 4) * 2 + (c >> 5), rr = r & 15, cc = c & 31, ob = rr * 64 + cc * 2; return st * 1024 + (ob ^ (((ob >> 9) & 1) << 5)); }
__host__ __device__ __forceinline__ void stage_rc(int b, int& R, int& C) { const int st = b / 1024, sb = b % 1024, swz = sb ^ (((sb >> 9) & 1) << 5); R = (st >> 1) * 16 + swz / 64; C = (st & 1) * 32 + (swz % 64) / 2; }
__host__ __device__ __forceinline__ int perm32(int rho) { const int n = rho >> 4, i = rho & 15; return 8 * (i >> 2) + 4 * n + (i & 3); }

struct Unit { int pm, pn; };
struct Gemm { const bf16_t* A; const bf16_t* Bt; int M, N, K, lda, ldb; };

struct StaticOrder {
    int nM, nN, nwg, G, c;
    __host__ __device__ void init(int M, int N, int G_, int c_) { nM = M / BM; nN = N / BM; nwg = nM * nN; G = G_; c = c_; }
    __host__ __device__ bool next(int i, Unit& u) const {
        const long L = (long)i * G + c; if (L >= nwg) return false;
        int wgid = (int)L; { const int q = nwg / NXCD, r = nwg % NXCD, xcd = wgid % NXCD, off = wgid / NXCD; wgid = (xcd < r ? xcd * (q + 1) : r * (q + 1) + (xcd - r) * q) + off; }
        const int nig = WGM * nN, gid = wgid / nig, fm = gid * WGM, gsz = (nM - fm) < WGM ? (nM - fm) : WGM;
        u.pm = fm + ((wgid % nig) % gsz); u.pn = (wgid % nig) / gsz; return true;
    }
    __device__ __forceinline__ void a_ready(const Unit&) const {}
    __device__ __forceinline__ void done(const Unit&) const {}
};
template <class Epi, class Sched, bool ALIGN_EPI = false, bool SP2 = false>
__device__ __forceinline__ void gemm_phase(PG8_LAS unsigned char* lds, const Gemm g, const Sched& S, const Epi& E) {
    int tid_ = threadIdx.x; asm volatile("" : "+v"(tid_));
    const int tid = tid_, wid = __builtin_amdgcn_readfirstlane(tid >> 6), lane = tid & 63, wr = wid >> 2, wc = wid & 3, fr = lane & 15, fq = lane >> 4;
    const int K = g.K, nt = K / BK;
    unsigned voffA[2], voffB[2];
#pragma unroll
    for (int i = 0; i < 2; ++i) { int R, C; stage_rc(tid * 16 + i * 8192, R, C); const int Rb = Epi::PERM ? ((R & ~31) + perm32(R & 31)) : R;
        voffA[i] = (unsigned)(R * g.lda + C) * 2u; voffB[i] = (unsigned)(Rb * g.ldb + C) * 2u; }
    const size_t kstep = (size_t)(BK * 2);
    const size_t hstepA = (size_t)HALF * g.lda * 2, hstepB = (size_t)HALF * g.ldb * 2;
    const size_t tstepA = 2 * hstepA, tstepB = 2 * hstepB;
    const unsigned ldsw = (unsigned)wid * 1024u;
    const int aoff = lds_byte(wr * 64 + fr, fq * 8), boff = lds_byte(wc * 32 + fr, fq * 8);
#define PG8_SA(b, h) (((b) * 2 + (h)) * HTB)
#define PG8_SB(b, h) ((4 + (b) * 2 + (h)) * HTB)
#define PG8_STAGE(bufoff, gbase, voff) do { _Pragma("unroll") for (int _i = 0; _i < 2; ++_i) \
        __builtin_amdgcn_global_load_lds((const unsigned*)((const char*)(gbase) + (voff)[_i]), (PG8_LAS unsigned*)(lds + (bufoff) + ldsw + _i * 8192), 16, 0, 0); } while (0)
#define PG8_LDA(dst, b, h) do { _Pragma("unroll") for (int m = 0; m < 4; ++m) _Pragma("unroll") for (int k = 0; k < 2; ++k) dst[m][k] = *(const PG8_LAS bf16x8*)(lds + PG8_SA(b, h) + aoff + m * 2048 + k * 1024); } while (0)
#define PG8_LDB(dst, b, h) do { _Pragma("unroll") for (int n = 0; n < 2; ++n) _Pragma("unroll") for (int k = 0; k < 2; ++k) dst[n][k] = *(const PG8_LAS bf16x8*)(lds + PG8_SB(b, h) + boff + n * 2048 + k * 1024); } while (0)
#define PG8_MMA(ai, bj, At, Bt) do { __builtin_amdgcn_s_setprio(1); _Pragma("unroll") for (int m = 0; m < 4; ++m) _Pragma("unroll") for (int n = 0; n < 2; ++n) _Pragma("unroll") for (int k = 0; k < 2; ++k) \
        acc[ai][bj][m][n] = __builtin_amdgcn_mfma_f32_16x16x32_bf16(Bt[n][k], At[m][k], acc[ai][bj][m][n], 0, 0, 0); __builtin_amdgcn_s_setprio(0); } while (0)
#define PG8_WAIT_V(n) asm volatile("s_waitcnt vmcnt(" #n ")" ::: "memory")
#define PG8_WAIT_L(n) asm volatile("s_waitcnt lgkmcnt(" #n ")" ::: "memory")
#define PG8_BAR __builtin_amdgcn_s_barrier()
#define PG8_SCHED __builtin_amdgcn_sched_barrier(0)
    Unit cur, nxt; int ui = 0;
    if (!S.next(0, cur)) return;
    f32x4 acc[2][2][4][2];
#pragma unroll
    for (int a = 0; a < 2; ++a)
#pragma unroll
        for (int b = 0; b < 2; ++b)
#pragma unroll
            for (int m = 0; m < 4; ++m)
#pragma unroll
                for (int n = 0; n < 2; ++n) acc[a][b][m][n] = (f32x4){0.f, 0.f, 0.f, 0.f};
    bf16x8 At[4][2], B0[2][2], B1[2][2];
    const char* cA = (const char*)g.A + (size_t)cur.pm * tstepA; const char* cB = (const char*)g.Bt + (size_t)cur.pn * tstepB;
    S.a_ready(cur);
    if constexpr (SP2) {
        PG8_STAGE(PG8_SB(0, 0), cB, voffB); PG8_STAGE(PG8_SB(0, 1), cB + hstepB, voffB); PG8_STAGE(PG8_SA(0, 0), cA, voffA); PG8_STAGE(PG8_SA(0, 1), cA + hstepA, voffA);
        if (wr == 1) PG8_BAR;
        PG8_WAIT_V(2); PG8_BAR;
        PG8_STAGE(PG8_SB(1, 0), cB + kstep, voffB); PG8_STAGE(PG8_SA(1, 0), cA + kstep, voffA); PG8_STAGE(PG8_SB(1, 1), cB + hstepB + kstep, voffB);
        PG8_WAIT_V(6); PG8_BAR;
    } else {
        PG8_STAGE(PG8_SB(0, 0), cB, voffB); PG8_STAGE(PG8_SA(0, 0), cA, voffA); PG8_STAGE(PG8_SB(0, 1), cB + hstepB, voffB); PG8_STAGE(PG8_SA(0, 1), cA + hstepA, voffA);
        if (wr == 1) PG8_BAR;
        PG8_WAIT_V(4); PG8_BAR;
        PG8_STAGE(PG8_SB(1, 0), cB + kstep, voffB); PG8_STAGE(PG8_SA(1, 0), cA + kstep, voffA); PG8_STAGE(PG8_SB(1, 1), cB + hstepB + kstep, voffB);
        PG8_WAIT_V(6); PG8_BAR;
    }
    for (;;) {
        const bool has_next = S.next(ui + 1, nxt);
        const char* nA = has_next ? (const char*)g.A + (size_t)nxt.pm * tstepA : cA; const char* nB = has_next ? (const char*)g.Bt + (size_t)nxt.pn * tstepB : cB;
#pragma unroll 1
        for (int t = 0; t < nt; t += 2) {
            const bool last = (t == nt - 2);
            const char* a1 = cA + (size_t)(t + 1) * kstep;
            const char* a2 = last ? nA : cA + (size_t)(t + 2) * kstep; const char* b2 = last ? nB : cB + (size_t)(t + 2) * kstep;
            const char* a3 = a2 + kstep; const char* b3 = b2 + kstep;
            if (last && has_next) S.a_ready(nxt);
            if constexpr (SP2) {
            PG8_LDB(B0, 0, 0); PG8_LDB(B1, 0, 1); PG8_SCHED; PG8_LDA(At, 0, 0); PG8_STAGE(PG8_SA(1, 1), a1 + hstepA, voffA);
            PG8_WAIT_V(8); PG8_WAIT_L(0); PG8_BAR; PG8_MMA(0, 0, At, B0); PG8_MMA(0, 1, At, B1); PG8_BAR; PG8_SCHED;
            PG8_LDA(At, 0, 1); PG8_STAGE(PG8_SB(0, 0), b2, voffB); PG8_STAGE(PG8_SB(0, 1), b2 + hstepB, voffB); PG8_STAGE(PG8_SA(0, 0), a2, voffA);
            PG8_WAIT_V(8); PG8_WAIT_L(0); PG8_BAR; PG8_MMA(1, 0, At, B0); PG8_MMA(1, 1, At, B1); PG8_BAR; PG8_SCHED;
            PG8_LDB(B0, 1, 0); PG8_LDB(B1, 1, 1); PG8_SCHED; PG8_LDA(At, 1, 0); PG8_STAGE(PG8_SA(0, 1), a2 + hstepA, voffA);
            PG8_WAIT_V(8); PG8_WAIT_L(0); PG8_BAR; PG8_MMA(0, 0, At, B0); PG8_MMA(0, 1, At, B1); PG8_BAR; PG8_SCHED;
            PG8_LDA(At, 1, 1); PG8_STAGE(PG8_SB(1, 0), b3, voffB); PG8_STAGE(PG8_SB(1, 1), b3 + hstepB, voffB); PG8_STAGE(PG8_SA(1, 0), a3, voffA);
            PG8_WAIT_V(8); PG8_WAIT_L(0); PG8_BAR; PG8_MMA(1, 0, At, B0); PG8_MMA(1, 1, At, B1); PG8_BAR; PG8_SCHED;
            } else {
            PG8_LDB(B0, 0, 0); PG8_SCHED; PG8_LDA(At, 0, 0); PG8_STAGE(PG8_SA(1, 1), a1 + hstepA, voffA);
            PG8_WAIT_L(8); PG8_BAR; PG8_WAIT_L(0); PG8_MMA(0, 0, At, B0); PG8_BAR; PG8_SCHED;
            PG8_LDB(B1, 0, 1); PG8_STAGE(PG8_SB(0, 0), b2, voffB);
            PG8_BAR; PG8_WAIT_L(0); PG8_MMA(0, 1, At, B1); PG8_BAR;
            PG8_LDA(At, 0, 1); PG8_STAGE(PG8_SA(0, 0), a2, voffA);
            PG8_BAR; PG8_WAIT_L(0); PG8_MMA(1, 0, At, B0); PG8_BAR; PG8_SCHED;
            PG8_STAGE(PG8_SB(0, 1), b2 + hstepB, voffB);
            PG8_WAIT_V(6); PG8_BAR; PG8_MMA(1, 1, At, B1); PG8_BAR;
            PG8_LDB(B0, 1, 0); PG8_SCHED; PG8_LDA(At, 1, 0); PG8_STAGE(PG8_SA(0, 1), a2 + hstepA, voffA);
            PG8_WAIT_L(8); PG8_BAR; PG8_WAIT_L(0); PG8_MMA(0, 0, At, B0); PG8_BAR; PG8_SCHED;
            PG8_LDB(B1, 1, 1); PG8_STAGE(PG8_SB(1, 0), b3, voffB);
            PG8_BAR; PG8_WAIT_L(0); PG8_MMA(0, 1, At, B1); PG8_BAR;
            PG8_LDA(At, 1, 1); PG8_STAGE(PG8_SA(1, 0), a3, voffA);
            PG8_BAR; PG8_WAIT_L(0); PG8_MMA(1, 0, At, B0); PG8_BAR; PG8_SCHED;
            PG8_STAGE(PG8_SB(1, 1), b3 + hstepB, voffB);
            PG8_WAIT_V(6); PG8_BAR; PG8_MMA(1, 1, At, B1); PG8_BAR;
            }
        }
        if constexpr (ALIGN_EPI) { if (wr == 0) PG8_BAR; }
        if constexpr (!Epi::AFTER_DRAIN) { E(acc, cur, wr, wc, fr, fq); S.done(cur); }
        if (!has_next) break;
#pragma unroll
        for (int a = 0; a < 2; ++a)
#pragma unroll
            for (int b = 0; b < 2; ++b)
#pragma unroll
                for (int m = 0; m < 4; ++m)
#pragma unroll
                    for (int n = 0; n < 2; ++n) acc[a][b][m][n] = (f32x4){0.f, 0.f, 0.f, 0.f};
        cur = nxt; cA = nA; cB = nB; ++ui;
        if constexpr (ALIGN_EPI) { if (wr == 1) PG8_BAR; }
    }
    PG8_WAIT_V(0);
    if constexpr (!ALIGN_EPI) { if (wr == 0) PG8_BAR; }
    PG8_BAR;
    if constexpr (Epi::AFTER_DRAIN) { E.fused(acc, cur, wr, wc, fr, fq, lds, wid, lane); S.done(cur); }
#undef PG8_SA
#undef PG8_SB
#undef PG8_STAGE
#undef PG8_LDA
#undef PG8_LDB
#undef PG8_MMA
#undef PG8_WAIT_V
#undef PG8_WAIT_L
#undef PG8_BAR
#undef PG8_SCHED
}
}

#define LAS __attribute__((address_space(3)))
typedef unsigned short bf16;
typedef pg8::f32x4 f32x4; typedef pg8::u32x4 u32x4; typedef pg8::bf16x8 bf16x8;
typedef float f32x16 __attribute__((ext_vector_type(16)));
typedef float f32x2 __attribute__((ext_vector_type(2)));
typedef __bf16 bf16x2_t __attribute__((ext_vector_type(2)));
typedef unsigned u32x2 __attribute__((ext_vector_type(2)));
typedef short s16x4 __attribute__((ext_vector_type(4)));

constexpr int DM = 1024, NBATCH = 8, SEQ = 4096, NMETA = 16, LTOK = 4112;
constexpr int MAINR = NBATCH * SEQ;
constexpr int RP = 33024;
constexpr int CROWS = NBATCH * LTOK;
constexpr int INC = 4096, DFF = 2816, UPC = 5632;
constexpr int NG = 32, NCHK = 257, NCP = 2304, UMK = 384;
constexpr float EPS = 1e-6f, LOG2E = 1.4426950408889634f;
constexpr int NWAVES = 8;

constexpr size_t MiB = 1u << 20;
constexpr size_t WS_BAR = 524288;
constexpr size_t WS_R1 = 0, WS_SS2 = 135168, WS_H1M = 274432, WS_LAM16 = 344064, WS_AM = 364544;
constexpr size_t WS_WIN = 1 * MiB, WS_WGLU = 9 * MiB, WS_WSO = 9 * MiB + 512 * 1024, WS_WAO = 10 * MiB + 512 * 1024, WS_WO = 11 * MiB + 512 * 1024,
                 WS_WUP = 13 * MiB + 512 * 1024, WS_WDN = 24 * MiB + 512 * 1024, WS_TE = 30 * MiB, WS_F = 36 * MiB, WS_CP = 40 * MiB, WS_BP = 43 * MiB, WS_AT = 46 * MiB;
constexpr size_t WS_XB = 50 * MiB;
constexpr size_t WS_UM = 115 * MiB, WS_H1B = WS_UM;
constexpr size_t WS_QB = 169 * MiB, WS_KB = WS_QB + 33816576, WS_VB = WS_KB + 33816576, WS_YSS = WS_QB, WS_PATT = WS_KB;
constexpr size_t WS_GSA = 266 * MiB, WS_EB = 395 * MiB, WS_YATT = 431 * MiB, WS_YG = WS_YATT + 33816576, WS_MIX = WS_YATT;
constexpr size_t WS_ACT = 202 * MiB;
constexpr size_t WS_SS2P = 496 * MiB;
constexpr size_t WS_END = 499 * MiB;
static_assert(WS_VB + 33816576 <= WS_GSA && WS_YG + 33816576 <= WS_END && WS_ACT + (size_t)MAINR * DFF * 2 <= WS_EB && WS_H1B + (size_t)RP * DM * 2 <= WS_ACT, "ws map");

constexpr int LDS_BYTES = 147456;
constexpr int LDS_X = 131072;

__device__ __forceinline__ unsigned cvtpk(float lo, float hi) { f32x2 v = {lo, hi}; bf16x2_t b = __builtin_convertvector(v, bf16x2_t); return __builtin_bit_cast(unsigned, b); }
__device__ __forceinline__ bf16 f2bf(float f) { return (bf16)(cvtpk(f, 0.f) & 0xffffu); }
__device__ __forceinline__ float bflo(unsigned u) { return __builtin_bit_cast(float, u << 16); }
__device__ __forceinline__ float bfhi(unsigned u) { return __builtin_bit_cast(float, u & 0xffff0000u); }
__device__ __forceinline__ void st8(bf16* p, f32x4 a, f32x4 b) { u32x4 w; w.x = cvtpk(a[0], a[1]); w.y = cvtpk(a[2], a[3]); w.z = cvtpk(b[0], b[1]); w.w = cvtpk(b[2], b[3]); *(u32x4*)p = w; }
__device__ __forceinline__ void ld8(const bf16* p, f32x4& a, f32x4& b) { const u32x4 w = *(const u32x4*)p; a = (f32x4){bflo(w.x), bfhi(w.x), bflo(w.y), bfhi(w.y)}; b = (f32x4){bflo(w.z), bfhi(w.z), bflo(w.w), bfhi(w.w)}; }
__device__ __forceinline__ void un8(const u32x4 w, f32x4& a, f32x4& b) { a = (f32x4){bflo(w.x), bfhi(w.x), bflo(w.y), bfhi(w.y)}; b = (f32x4){bflo(w.z), bfhi(w.z), bflo(w.w), bfhi(w.w)}; }
__device__ __forceinline__ unsigned q8x4(f32x4 s) { const f32x4 t = s * 255.f + 0.5f; return (unsigned)t[0] | ((unsigned)t[1] << 8) | ((unsigned)t[2] << 16) | ((unsigned)t[3] << 24); }
__device__ __forceinline__ f32x4 dq8x4(unsigned w) { return (f32x4){(float)(w & 0xffu), (float)((w >> 8) & 0xffu), (float)((w >> 16) & 0xffu), (float)(w >> 24)} * (1.f / 255.f); }
__device__ __forceinline__ float fsig(float x) { return __builtin_amdgcn_rcpf(1.f + __builtin_amdgcn_exp2f(-LOG2E * x)); }
__device__ __forceinline__ float fgelu(float x) { const float t = x * (-2.302208198f - 0.1029432397f * x * x); return x * __builtin_amdgcn_rcpf(1.f + __builtin_amdgcn_exp2f(t)); }
__device__ __forceinline__ f32x4 sig4(f32x4 v) { return (f32x4){fsig(v[0]), fsig(v[1]), fsig(v[2]), fsig(v[3])}; }
__device__ __forceinline__ f32x4 gelu4(f32x4 v) { return (f32x4){fgelu(v[0]), fgelu(v[1]), fgelu(v[2]), fgelu(v[3])}; }
__device__ __forceinline__ float wave_sum(float v) {
#pragma unroll
    for (int o = 1; o < 64; o <<= 1) v += __shfl_xor(v, o);
    return v;
}
__device__ __forceinline__ float sq4(f32x4 v) { return (v[0] * v[0] + v[1] * v[1]) + (v[2] * v[2] + v[3] * v[3]); }

struct Params { const float* in[29]; float* out; unsigned char* ws; int ph_lo, ph_hi; };
typedef const __attribute__((address_space(4))) unsigned char* kaptr_t;
__device__ __forceinline__ kaptr_t KA() { kaptr_t ka = (kaptr_t)__builtin_amdgcn_kernarg_segment_ptr(); asm volatile("" : "+s"(ka)); return ka; }
#define KARG64(off) (*(const __attribute__((address_space(4))) unsigned long long*)(KA() + (off)))
#define GAS __attribute__((address_space(1)))
#define INP(k) ((const float*)(GAS const float*)KARG64(8 * (k)))
#define OUTP() ((float*)(GAS float*)KARG64(232))
#define WSP() ((unsigned char*)(GAS unsigned char*)KARG64(240))
static_assert(sizeof(Params) == 256, "Params layout");

template <class F> struct EpiG {
    static constexpr bool PERM = true, AFTER_DRAIN = false; F f;
    __device__ __forceinline__ void operator()(const f32x4 (&acc)[2][2][4][2], const pg8::Unit& u, int wr, int wc, int fr, int fq) const {
        const int cl = u.pn * 256 + 64 * wc + 8 * fq, row0 = u.pm * 256 + wr * 64 + fr;
        typename F::Pre pre = f.load(row0, cl);
#pragma unroll
        for (int i = 0; i < 8; ++i) {
            const int ai = i >> 2, m = i & 3, row = row0 + ai * 128 + m * 16;
            typename F::Pre nxt = pre;
            if (i + 1 < 8) nxt = f.load(row0 + ((i + 1) >> 2) * 128 + ((i + 1) & 3) * 16, cl);
            f.apply(row, cl, pre, acc[ai][0][m][0], acc[ai][0][m][1], acc[ai][1][m][0], acc[ai][1][m][1]);
            pre = nxt;
        }
    }
};
template <class F> __device__ __forceinline__ void skinny_task(const bf16* A16, int lda, const bf16* Bt, int ldb, int K, int pn, int wc, int lane, int wave, LAS float* red, int rowbase, int clbase, const F& f) {
    const int fr = lane & 15, fq = lane >> 4;
    typename F::Pre pre = f.load(rowbase + fr, clbase + 8 * fq);
    f32x4 c00 = {0.f, 0.f, 0.f, 0.f}, c01 = c00, c10 = c00, c11 = c00;
    const bf16* tb = Bt + (size_t)(pn * 256 + 32 * wc) * ldb + fq * 8;
    const bf16* b00 = tb + (size_t)pg8::perm32(fr) * ldb; const bf16* b01 = tb + (size_t)pg8::perm32(16 + fr) * ldb;
    const bf16* b10 = b00 + (size_t)128 * ldb; const bf16* b11 = b01 + (size_t)128 * ldb;
    const bf16* ap = A16 + (size_t)fr * lda + fq * 8;
#pragma unroll 4
    for (int k0 = 32 * wave; k0 < K; k0 += 256) {
        const bf16x8 a = *(const bf16x8*)(ap + k0);
        const bf16x8 v00 = *(const bf16x8*)(b00 + k0), v01 = *(const bf16x8*)(b01 + k0), v10 = *(const bf16x8*)(b10 + k0), v11 = *(const bf16x8*)(b11 + k0);
        c00 = __builtin_amdgcn_mfma_f32_16x16x32_bf16(v00, a, c00, 0, 0, 0); c01 = __builtin_amdgcn_mfma_f32_16x16x32_bf16(v01, a, c01, 0, 0, 0);
        c10 = __builtin_amdgcn_mfma_f32_16x16x32_bf16(v10, a, c10, 0, 0, 0); c11 = __builtin_amdgcn_mfma_f32_16x16x32_bf16(v11, a, c11, 0, 0, 0);
    }
    LAS f32x4* R = (LAS f32x4*)red + (wave * 4) * 64 + lane;
    R[0] = c00; R[64] = c01; R[128] = c10; R[192] = c11;
    __syncthreads();
    if (wave == 0) {
        LAS const f32x4* S = (LAS const f32x4*)red + lane;
#pragma unroll
        for (int w = 1; w < 8; ++w) { c00 += S[(w * 4) * 64]; c01 += S[(w * 4 + 1) * 64]; c10 += S[(w * 4 + 2) * 64]; c11 += S[(w * 4 + 3) * 64]; }
        f.apply(rowbase + fr, clbase + 8 * fq, pre, c00, c01, c10, c11);
    }
    __syncthreads();
}
template <class F> __device__ __forceinline__ void skinny16(const bf16* A16, int lda, const bf16* Bt, int ldb, int N, int K, int bx, int G, int lane, int wave, LAS float* red, const F& f, int boff = 0) {
    asm volatile("" : "+v"(lane));
    for (int t = (bx - boff + G) % G; t < N / 64; t += G) skinny_task(A16, lda, Bt, ldb, K, t >> 2, t & 3, lane, wave, red, MAINR, t * 64, f);
}
template <class F> __device__ __forceinline__ void skinny_ssm(const bf16* UMp, const bf16* Bt, int ldb, int K, int bx, int G, int lane, int wave, LAS float* red, const F& f) {
    asm volatile("" : "+v"(lane));
    for (int t = bx; t < NG * 4; t += G) { const int g = t >> 2, wc = t & 3;
        skinny_task(UMp + (size_t)(g * NCP + 2048) * UMK, UMK, Bt + (size_t)g * 256 * ldb, ldb, K, 0, wc, lane, wave, red, g * NCP + 2048, g * 256 + 64 * wc, f); }
}

struct FIn {
    const float* r1; bf16* UM; bf16* QB; bf16* KB; bf16* VB; bf16* GSA; const float* qg; const float* kg;
    struct Pre { float r; };
    __device__ __forceinline__ Pre load(int row, int) const { return Pre{r1[row]}; }
    __device__ __forceinline__ void apply(int row, int cl, const Pre& P_, f32x4 a0, f32x4 a1, f32x4 b0, f32x4 b1) const {
        const float r = P_.r; a0 *= r; a1 *= r; b0 *= r; b1 *= r;
        const int g64 = cl & ~63;
        const bool meta = row >= MAINR;
        const int bb = row >> 12, tt = meta ? row - MAINR : 16 + (row & 4095);
        if (g64 < 512) {
            const int nb0 = meta ? 0 : bb, nb1 = meta ? NBATCH : bb + 1;
            for (int b = nb0; b < nb1; ++b) {
                const size_t base = (size_t)(b * NCHK + (tt >> 4)) * UMK + (tt & 15) * 16;
                st8(UM + (size_t)(cl >> 4) * NCP * UMK + base + (cl & 15), a0, a1);
                st8(UM + (size_t)((cl + 32) >> 4) * NCP * UMK + base + (cl & 15), b0, b1);
            }
        } else if (g64 < 2048) {
            const int sel = (g64 - 512) >> 9;
            bf16* dst = QB + (size_t)sel * 16908288; const int cc = cl - 512 - sel * 512;
            if (sel < 2) {
                float ss = (sq4(a0) + sq4(a1)) + (sq4(b0) + sq4(b1));
                ss += __shfl_xor(ss, 16); ss += __shfl_xor(ss, 32);
                const float rr = __builtin_amdgcn_rsqf(ss * (1.f / 64.f) + EPS) * (sel == 0 ? 0.125f * LOG2E : 1.f);
                const float* gp = qg + sel * (kg - qg) + (cl & 63);
                const f32x4 g0 = *(const f32x4*)gp, g1 = *(const f32x4*)(gp + 4), g2 = *(const f32x4*)(gp + 32), g3 = *(const f32x4*)(gp + 36);
                a0 = a0 * rr * g0; a1 = a1 * rr * g1; b0 = b0 * rr * g2; b1 = b1 * rr * g3;
            }
            const int nb0 = meta ? 0 : bb, nb1 = meta ? NBATCH : bb + 1;
            for (int b = nb0; b < nb1; ++b) { bf16* p = dst + (size_t)(b * LTOK + tt) * 512 + cc; st8(p, a0, a1); st8(p + 32, b0, b1); }
        } else {
            unsigned char* p = (unsigned char*)GSA + (size_t)row * 2048 + (cl - 2048);
            u32x2 w0, w1; w0.x = q8x4(sig4(a0)); w0.y = q8x4(sig4(a1)); w1.x = q8x4(sig4(b0)); w1.y = q8x4(sig4(b1));
            __builtin_nontemporal_store(w0, (u32x2*)p); __builtin_nontemporal_store(w1, (u32x2*)(p + 32));
        }
    }
};
struct FE {
    float* EB;
    struct Pre {};
    __device__ __forceinline__ Pre load(int, int) const { return Pre{}; }
    __device__ __forceinline__ void apply(int row, int cl, const Pre&, f32x4 a0, f32x4 a1, f32x4 b0, f32x4 b1) const {
        const int s = cl & 255;
        if (s < 128) { float* p = EB + (size_t)row * 128 + s; *(f32x4*)p = a0; *(f32x4*)(p + 4) = a1; *(f32x4*)(p + 32) = b0; *(f32x4*)(p + 36) = b1; }
    }
};
struct FY {
    bf16* YG;
    struct Pre {};
    __device__ __forceinline__ Pre load(int, int) const { return Pre{}; }
    __device__ __forceinline__ void apply(int row, int cl, const Pre&, f32x4 a0, f32x4 a1, f32x4 b0, f32x4 b1) const {
        const int g = row / NCP, n = row - g * NCP;
        if (n >= NBATCH * NCHK) return;
        const int b = n / NCHK, ch = n - b * NCHK, lc = cl & 255, c = lc & 15;
        const int tok0 = ch * 16 + (lc >> 4), tok1 = tok0 + 2;
        int o0, o1;
        if (ch == 0) { if (b != 0) return; o0 = MAINR + tok0; o1 = MAINR + tok1; } else { o0 = b * 4096 + tok0 - 16; o1 = o0 + 2; }
        st8(YG + (size_t)o0 * 512 + g * 16 + c, gelu4(a0), gelu4(a1));
        st8(YG + (size_t)o1 * 512 + g * 16 + c, gelu4(b0), gelu4(b1));
    }
};
struct FGlu {
    const bf16* YG; bf16* YSS; const float* bias;
    struct Pre { u32x4 y0, y1; };
    __device__ __forceinline__ Pre load(int row, int cl) const { const bf16* yp = YG + (size_t)row * 512 + cl; return Pre{*(const u32x4*)yp, *(const u32x4*)(yp + 32)}; }
    __device__ __forceinline__ void apply(int row, int cl, const Pre& P_, f32x4 a0, f32x4 a1, f32x4 b0, f32x4 b1) const {
        const float* bp = bias + cl;
        f32x4 y0, y1, y2, y3; un8(P_.y0, y0, y1); un8(P_.y1, y2, y3);
        a0 = y0 * sig4(a0 + *(const f32x4*)bp); a1 = y1 * sig4(a1 + *(const f32x4*)(bp + 4)); b0 = y2 * sig4(b0 + *(const f32x4*)(bp + 32)); b1 = y3 * sig4(b1 + *(const f32x4*)(bp + 36));
        bf16* p = YSS + (size_t)row * 512 + cl; st8(p, a0, a1); st8(p + 32, b0, b1);
    }
};
struct FPatt {
    const bf16* GSA; bf16* PATT;
    struct Pre { u32x2 g0, g1; };
    __device__ __forceinline__ Pre load(int row, int cl) const { const unsigned char* gp = (const unsigned char*)GSA + (size_t)row * 2048 + 1024 + cl; return Pre{__builtin_nontemporal_load((const u32x2*)gp), __builtin_nontemporal_load((const u32x2*)(gp + 32))}; }
    __device__ __forceinline__ void apply(int row, int cl, const Pre& P_, f32x4 a0, f32x4 a1, f32x4 b0, f32x4 b1) const {
        const f32x4 g0 = dq8x4(P_.g0.x), g1 = dq8x4(P_.g0.y), g2 = dq8x4(P_.g1.x), g3 = dq8x4(P_.g1.y);
        bf16* p = PATT + (size_t)row * 1024 + cl; st8(p, a0 * g0, a1 * g1); st8(p + 32, b0 * g2, b1 * g3);
    }
};
struct FMix {
    const bf16* GSA; const bf16* PATT; bf16* MIX;
    struct Pre { u32x2 g0, g1; u32x4 q0, q1; };
    __device__ __forceinline__ Pre load(int row, int cl) const { const unsigned char* gp = (const unsigned char*)GSA + (size_t)row * 2048 + cl; const bf16* pp = PATT + (size_t)row * 1024 + cl;
        return Pre{__builtin_nontemporal_load((const u32x2*)gp), __builtin_nontemporal_load((const u32x2*)(gp + 32)), __builtin_nontemporal_load((const u32x4*)pp), __builtin_nontemporal_load((const u32x4*)(pp + 32))}; }
    __device__ __forceinline__ void apply(int row, int cl, const Pre& P_, f32x4 a0, f32x4 a1, f32x4 b0, f32x4 b1) const {
        const f32x4 g0 = dq8x4(P_.g0.x), g1 = dq8x4(P_.g0.y), g2 = dq8x4(P_.g1.x), g3 = dq8x4(P_.g1.y);
        f32x4 p0, p1, p2, p3; un8(P_.q0, p0, p1); un8(P_.q1, p2, p3);
        bf16* p = MIX + (size_t)row * 1024 + cl; st8(p, p0 + a0 * g0, p1 + a1 * g1); st8(p + 32, p2 + b0 * g2, p3 + b1 * g3);
    }
};
struct FWo {
    const bf16* XB; bf16* H1B; float* ss2;
    struct Pre { u32x4 h0, h1; };
    __device__ __forceinline__ Pre load(int row, int cl) const { const bf16* hp = XB + (size_t)row * 1024 + cl; return Pre{__builtin_nontemporal_load((const u32x4*)hp), __builtin_nontemporal_load((const u32x4*)(hp + 32))}; }
    __device__ __forceinline__ void apply(int row, int cl, const Pre& P_, f32x4 a0, f32x4 a1, f32x4 b0, f32x4 b1) const {
        f32x4 h0, h1, h2, h3; un8(P_.h0, h0, h1); un8(P_.h1, h2, h3);
        a0 += h0; a1 += h1; b0 += h2; b1 += h3;
        bf16* p = H1B + (size_t)row * 1024 + cl; st8(p, a0, a1); st8(p + 32, b0, b1);
        float ss = (sq4(a0) + sq4(a1)) + (sq4(b0) + sq4(b1));
        ss += __shfl_xor(ss, 16); ss += __shfl_xor(ss, 32);
        if ((threadIdx.x & 63) < 16) atomicAdd(ss2 + row, ss);
    }
};
struct FDown {
    const bf16* H1B; float* out;
    struct Pre { u32x4 h0, h1; };
    __device__ __forceinline__ Pre load(int row, int cl) const { const bf16* hp = H1B + (size_t)row * 1024 + cl; return Pre{__builtin_nontemporal_load((const u32x4*)hp), __builtin_nontemporal_load((const u32x4*)(hp + 32))}; }
    __device__ __forceinline__ void apply(int row, int cl, const Pre& P_, f32x4 a0, f32x4 a1, f32x4 b0, f32x4 b1) const {
        f32x4 h0, h1, h2, h3; un8(P_.h0, h0, h1); un8(P_.h1, h2, h3);
        float* op = out + (size_t)row * 1024 + cl;
        __builtin_nontemporal_store(a0 + h0, (f32x4*)op); __builtin_nontemporal_store(a1 + h1, (f32x4*)(op + 4)); __builtin_nontemporal_store(b0 + h2, (f32x4*)(op + 32)); __builtin_nontemporal_store(b1 + h3, (f32x4*)(op + 36));
    }
};
__device__ __forceinline__ float row_rs(const float* ss2p, int row) {
    const f32x4* q = (const f32x4*)(ss2p + (size_t)row * 16); const f32x4 a = q[0], b = q[1], c = q[2], d = q[3];
    const f32x4 s = (a + b) + (c + d); return __builtin_amdgcn_rsqf(((s[0] + s[1]) + (s[2] + s[3])) * (1.f / 1024.f) + EPS);
}
struct FUpMeta {
    const float* ss2; float* AM;
    struct Pre {};
    __device__ __forceinline__ Pre load(int, int) const { return Pre{}; }
    __device__ __forceinline__ void apply(int row, int cl, const Pre&, f32x4 a0, f32x4 a1, f32x4 b0, f32x4 b1) const {
        const int t = row - MAINR; if (t < 14) return;
        const float r = __builtin_amdgcn_rsqf(ss2[row] * (1.f / 1024.f) + EPS);
        const int hid = 128 * (cl >> 8) + 32 * ((cl >> 6) & 3) + (cl & 31);
        float* p = AM + (size_t)(t - 14) * DFF + hid; *(f32x4*)p = a0 * r; *(f32x4*)(p + 4) = a1 * r;
    }
};

__device__ __forceinline__ float rot1(float v) { float r = __builtin_bit_cast(float, __builtin_amdgcn_update_dpp(0, __builtin_bit_cast(int, v), 0x121, 0xf, 0xf, false)); asm volatile("" : "+v"(r)); return r; }
__device__ __forceinline__ float rot2(float v) { float r = __builtin_bit_cast(float, __builtin_amdgcn_update_dpp(0, __builtin_bit_cast(int, v), 0x122, 0xf, 0xf, false)); asm volatile("" : "+v"(r)); return r; }
struct EpiUp {
    static constexpr bool PERM = true, AFTER_DRAIN = false;
    const float* ss2; const float* cw; const float* cb; bf16* ACT; float* CP; float* BP; float* AT; LAS float* tails;
    __device__ __forceinline__ void operator()(const f32x4 (&acc)[2][2][4][2], const pg8::Unit& u, int wr, int wc, int fr, int fq) const {
        const int hid = 128 * u.pn + 32 * wc + 8 * fq;
        f32x4 w0[2], w1[2], w2[2], bv[2];
#pragma unroll
        for (int n = 0; n < 2; ++n) { w0[n] = *(const f32x4*)(cw + hid + 4 * n); w1[n] = *(const f32x4*)(cw + DFF + hid + 4 * n); w2[n] = *(const f32x4*)(cw + 2 * DFF + hid + 4 * n); bv[n] = *(const f32x4*)(cb + hid + 4 * n); }
        LAS f32x4* T = (LAS f32x4*)tails;
        float rs[2][4];
#pragma unroll
        for (int ai = 0; ai < 2; ++ai)
#pragma unroll
            for (int m = 0; m < 4; ++m) rs[ai][m] = __builtin_amdgcn_rsqf(ss2[u.pm * 256 + ai * 128 + wr * 64 + m * 16 + fr] * (1.f / 1024.f) + EPS);
        if (fr >= 14) {
#pragma unroll
            for (int ai = 0; ai < 2; ++ai)
#pragma unroll
                for (int n = 0; n < 2; ++n) T[((((ai * 2 + wr) * 4 + wc) * 2 + n) * 4 + fq) * 2 + (fr - 14)] = acc[ai][0][3][n] * rs[ai][3];
        }
        asm volatile("s_waitcnt lgkmcnt(0)" ::: "memory"); __builtin_amdgcn_s_barrier(); asm volatile("" ::: "memory");
#pragma unroll
        for (int ai = 0; ai < 2; ++ai) {
            const int band = ai * 2 + wr;
            f32x4 pm1[2];
#pragma unroll
            for (int n = 0; n < 2; ++n) { pm1[n] = (f32x4){0.f, 0.f, 0.f, 0.f}; if (band > 0 && fr >= 14) pm1[n] = T[(((( band - 1) * 4 + wc) * 2 + n) * 4 + fq) * 2 + (fr - 14)]; }
#pragma unroll
            for (int m = 0; m < 4; ++m) {
                const int row = u.pm * 256 + ai * 128 + wr * 64 + m * 16 + fr;
                f32x4 o[2], bo[2];
#pragma unroll
                for (int n = 0; n < 2; ++n) {
                    const f32x4 xa = acc[ai][0][m][n] * rs[ai][m];
                    const f32x4 xp = (m == 0) ? pm1[n] : acc[ai][0][m - 1][n] * rs[ai][m - 1];
                    bo[n] = acc[ai][1][m][n] * rs[ai][m];
#pragma unroll
                    for (int j = 0; j < 4; ++j) {
                        const float r1a = rot1(xa[j]), r1p = rot1(xp[j]), r2a = rot2(xa[j]), r2p = rot2(xp[j]);
                        const float p1 = fr >= 1 ? r1a : r1p;
                        const float p2 = fr >= 2 ? r2a : r2p;
                        o[n][j] = bv[n][j] + w2[n][j] * xa[j] + w1[n][j] * p1 + w0[n][j] * p2;
                    }
                }
                if (band == 0 && m == 0 && fr < 2) {
                    float* cp = CP + (size_t)(u.pm * 2 + fr) * DFF + hid; float* bp = BP + (size_t)(u.pm * 2 + fr) * DFF + hid;
                    *(f32x4*)cp = o[0]; *(f32x4*)(cp + 4) = o[1]; *(f32x4*)bp = bo[0]; *(f32x4*)(bp + 4) = bo[1];
                } else {
                    st8(ACT + (size_t)row * DFF + hid, gelu4(o[0]) * bo[0], gelu4(o[1]) * bo[1]);
                }
                if (band == 3 && m == 3 && fr >= 14) {
                    float* ap = AT + (size_t)(u.pm * 2 + fr - 14) * DFF + hid;
                    *(f32x4*)ap = acc[ai][0][m][0] * rs[ai][m]; *(f32x4*)(ap + 4) = acc[ai][0][m][1] * rs[ai][m];
                }
            }
        }
    }
};

struct SsmOrder {
    int G, c;
    __device__ __forceinline__ bool next(int i, pg8::Unit& u) const { const int L = i * G + c; if (L >= NG * 8) return false; u.pm = (L >> 3) * 9 + (L & 7); u.pn = L >> 3; return true; }
    __device__ __forceinline__ void a_ready(const pg8::Unit&) const {}
    __device__ __forceinline__ void done(const pg8::Unit&) const {}
};
#define XB_TMO      128
#define XB_XCNT(j)  (256  + 64 * (j))
#define XB_XSUB(j)  (1280 + 64 * (j))
#define XB_XGEN(j)  (2304 + 64 * (j))
#define XB_TOP      3328
#define XB_TOPGEN   3392
#define XCD_BAR_WORDS 3456
#define XB_SPIN_CAP (1u << 18)

__device__ __forceinline__ unsigned xb_ld(unsigned* p)              { return __hip_atomic_load(p, __ATOMIC_RELAXED, __HIP_MEMORY_SCOPE_AGENT); }
__device__ __forceinline__ unsigned xb_add(unsigned* p, unsigned v) { return __hip_atomic_fetch_add(p, v, __ATOMIC_RELAXED, __HIP_MEMORY_SCOPE_AGENT); }
__device__ __forceinline__ unsigned xb_xcc_id() { return (unsigned)__builtin_amdgcn_s_getreg((3 << 11) | 20) & 0xFu; }
#define XB_SPIN(cond, bar) do { unsigned _sp = 0; while (cond) { __builtin_amdgcn_s_sleep(1); \
    if ((++_sp & 255u) == 0u) { if (xb_ld(&(bar)[XB_TMO])) break; if (_sp > XB_SPIN_CAP) { atomicAdd(&(bar)[XB_TMO], 1u); break; } } } } while (0)

struct XcdBarrier {
    unsigned* bar; unsigned x;
    volatile LAS unsigned* st;
};

__device__ __forceinline__ XcdBarrier xcd_barrier_post(unsigned* bar, volatile LAS unsigned* st) {
    XcdBarrier b; b.bar = bar; b.x = xb_xcc_id(); b.st = st;
    if (threadIdx.x == 0) (void)xb_add(&bar[XB_XCNT(b.x)], 1u);
    return b;
}
__device__ __forceinline__ void xcd_barrier_complete(unsigned* bar, unsigned x, unsigned& nloc, unsigned& nx) {
    const unsigned G = gridDim.x * gridDim.y * gridDim.z;
    unsigned sum, cnt, mine, sp = 0u;
    for (;;) {
        sum = 0u; cnt = 0u; mine = 0u;
#pragma unroll
        for (unsigned j = 0; j < 16; ++j) { const unsigned c = xb_ld(&bar[XB_XCNT(j)]); sum += c; cnt += (c > 0u) ? 1u : 0u; mine = (j == x) ? c : mine; }
        if (sum == G) break;
        __builtin_amdgcn_s_sleep(1);
        if ((++sp & 255u) == 0u) { if (xb_ld(&bar[XB_TMO])) break; if (sp > XB_SPIN_CAP) { atomicAdd(&bar[XB_TMO], 1u); break; } }
    }
    nloc = mine > 0u ? mine : 1u; nx = cnt > 0u ? cnt : 1u;
}

__device__ __forceinline__ void xcd_barrier(const XcdBarrier& b) {
    asm volatile("s_waitcnt vmcnt(0)" ::: "memory");
    __syncthreads();
    if (threadIdx.x == 0) {
        unsigned* bar = b.bar;
        __builtin_amdgcn_s_waitcnt(0);
        unsigned nloc = b.st[0], nx = b.st[1];
        if (nloc == 0u) { xcd_barrier_complete(bar, b.x, nloc, nx); b.st[0] = nloc; b.st[1] = nx; }
        const unsigned old = xb_add(&bar[XB_XSUB(b.x)], 1u);
        const unsigned gen = old / nloc;
        if (old + 1u == (gen + 1u) * nloc) {
            __builtin_amdgcn_fence(__ATOMIC_RELEASE, "agent");
            asm volatile("s_waitcnt vmcnt(0)" ::: "memory");
            const unsigned og = xb_add(&bar[XB_TOP], 1u);
            const unsigned tg = og / nx;
            if (og + 1u == (tg + 1u) * nx) xb_add(&bar[XB_TOPGEN], 1u);
            else XB_SPIN(xb_ld(&bar[XB_TOPGEN]) == tg, bar);
            __builtin_amdgcn_fence(__ATOMIC_ACQUIRE, "agent");
            xb_add(&bar[XB_XGEN(b.x)], 1u);
            asm volatile("s_waitcnt vmcnt(0)" ::: "memory");
        } else {
            XB_SPIN(xb_ld(&bar[XB_XGEN(b.x)]) == gen, bar);
            __builtin_amdgcn_fence(__ATOMIC_ACQUIRE, "agent");
            asm volatile("s_waitcnt vmcnt(0)" ::: "memory");
        }
    }
    __syncthreads();
}

constexpr int AK_STRIDE = 144, AK_BYTES = 64 * AK_STRIDE, AV_BYTES = 16384, A_KOFF = 0, A_VOFF = 4 * AK_BYTES, A_STASH = A_VOFF + 2 * AV_BYTES;
__device__ __forceinline__ int crow(int r, int hi) { return (r & 3) + 8 * (r >> 2) + 4 * hi; }
__device__ __forceinline__ s16x4 vtr(LAS const unsigned char* p) { typedef short v4i16_t __attribute__((ext_vector_type(4))); return __builtin_bit_cast(s16x4, __builtin_amdgcn_ds_read_tr16_b64_v4i16((LAS v4i16_t*)p)); }

__device__ __forceinline__ void attn_unit(const bf16* __restrict__ QB, const bf16* __restrict__ KB, const bf16* __restrict__ VB, bf16* __restrict__ YATT,
                                          const float* __restrict__ sg, float lam, int b, int h, int q0, int jstart, int D, int NT, LAS unsigned char* lds) {
    int tid_ = threadIdx.x; asm volatile("" : "+v"(tid_));
    const int tid = tid_, lane = tid & 63, r32 = lane & 31, hi = lane >> 5; const int wid = __builtin_amdgcn_readfirstlane(tid >> 6);
    const int jc = wid >> 2, w4 = wid & 3, hj = 2 * h + jc;
    const float slope = __builtin_amdgcn_exp2f(-2.f * (float)(h + 1)) * LOG2E;
    const bf16* Kg = KB + (size_t)(b * LTOK) * 512 + (2 * h) * 64;
    const bf16* Vg = VB + (size_t)(b * LTOK) * 512 + h * 128;
    const int tq = q0 + 32 * w4 + r32, tqc = tq < 0 ? 0 : tq;
    const int qref = q0 + 32 * w4;
    bf16x8 qr[4];
    { const bf16* Qrow = QB + (size_t)(b * LTOK + tqc) * 512 + hj * 64;
#pragma unroll
      for (int d0 = 0; d0 < 4; ++d0) qr[d0] = *(const bf16x8*)(Qrow + d0 * 16 + hi * 8); }
    const int jmax = (qref + 31) >> 6;
    const int jsw = qref - D > 0 ? (qref - D) >> 6 : 0;
    const int jd = qref >> 6;
    const float s_hi_f = bflo((unsigned)f2bf(slope)), s_lo_f = slope - s_hi_f;
    u32x4 bexw = {0u, 0u, 0u, 0u}, aex0w = {0u, 0u, 0u, 0u}, aex1w = {0u, 0u, 0u, 0u};
    if (hi == 0) { bexw.x = cvtpk(s_hi_f, s_lo_f); bexw.y = cvtpk(64.f * s_hi_f, 64.f * s_lo_f); aex0w.x = cvtpk((float)r32, (float)r32); aex1w.x = cvtpk((float)(32 + r32), (float)(32 + r32)); }
    const bf16x8 bex = __builtin_bit_cast(bf16x8, bexw);
    const bf16* ksrc[2]; int kdst[2];
#pragma unroll
    for (int i = 0; i < 2; ++i) { const int idx = tid + 512 * i, comp = idx >> 9, key = (idx >> 3) & 63, ch = idx & 7; ksrc[i] = Kg + (size_t)key * 512 + comp * 64 + ch * 8; kdst[i] = comp * AK_BYTES + key * AK_STRIDE + ch * 16; }
    const bf16* vsrc[2]; int vdst[2];
#pragma unroll
    for (int i = 0; i < 2; ++i) { const int idx = tid + 512 * i, key = idx >> 4, ch = idx & 15; vsrc[i] = Vg + (size_t)key * 512 + ch * 8; vdst[i] = ((key >> 3) * 4 + (ch >> 2)) * 512 + (key & 7) * 64 + (ch & 3) * 16; }
    LAS unsigned char* Kl = lds + A_KOFF; LAS unsigned char* Vl = lds + A_VOFF;
    const int kfo = jc * AK_BYTES + r32 * AK_STRIDE + hi * 16;
    const int vb = (4 * hi + ((lane & 15) >> 2)) * 64 + ((lane >> 4) & 1) * 32 + (lane & 3) * 8;
    f32x16 acc[4];
#pragma unroll
    for (int e = 0; e < 4; ++e) acc[e] = f32x16{};
    f32x16 negc = f32x16{};
    float lrun = 0.f;
    constexpr float THR = 60.f;
    u32x4 kreg[2], vreg[2];
    { const size_t go = (size_t)jstart * 64 * 512; kreg[0] = *(const u32x4*)(ksrc[0] + go); kreg[1] = *(const u32x4*)(ksrc[1] + go); vreg[0] = *(const u32x4*)(vsrc[0] + go); vreg[1] = *(const u32x4*)(vsrc[1] + go); }
    *(LAS u32x4*)(Kl + kdst[0]) = kreg[0]; *(LAS u32x4*)(Kl + kdst[1]) = kreg[1]; *(LAS u32x4*)(Vl + vdst[0]) = vreg[0]; *(LAS u32x4*)(Vl + vdst[1]) = vreg[1];
    __syncthreads();
    for (int j = jstart; j < NT; ++j) {
        const int cur = (j - jstart) & 1;
        if (j + 1 < NT) { const size_t go = (size_t)(j + 1) * 64 * 512; kreg[0] = *(const u32x4*)(ksrc[0] + go); kreg[1] = *(const u32x4*)(ksrc[1] + go); vreg[0] = *(const u32x4*)(vsrc[0] + go); vreg[1] = *(const u32x4*)(vsrc[1] + go); }
        if (j >= jsw && j <= jmax) {
            LAS const unsigned char* Kc = Kl + cur * 2 * AK_BYTES + kfo; LAS const unsigned char* Vc = Vl + cur * AV_BYTES + vb;
            { const float jr = (float)(j - jd); const unsigned jw = hi == 0 ? cvtpk(jr, jr) : 0u; aex0w.y = jw; aex1w.y = jw; }
            f32x16 s0 = __builtin_amdgcn_mfma_f32_32x32x16_bf16(__builtin_bit_cast(bf16x8, aex0w), bex, negc, 0, 0, 0);
            f32x16 s1 = __builtin_amdgcn_mfma_f32_32x32x16_bf16(__builtin_bit_cast(bf16x8, aex1w), bex, negc, 0, 0, 0);
#pragma unroll
            for (int d0 = 0; d0 < 4; ++d0) {
                const bf16x8 k0 = *(LAS const bf16x8*)(Kc + d0 * 32);
                const bf16x8 k1 = *(LAS const bf16x8*)(Kc + 32 * AK_STRIDE + d0 * 32);
                s0 = __builtin_amdgcn_mfma_f32_32x32x16_bf16(k0, qr[d0], s0, 0, 0, 0);
                s1 = __builtin_amdgcn_mfma_f32_32x32x16_bf16(k1, qr[d0], s1, 0, 0, 0);
            }
            if (64 * j + 63 > qref) {
                const int qrel = tqc - 64 * j - 4 * hi;
#pragma unroll
                for (int r = 0; r < 16; ++r) { const int kk = (r & 3) + 8 * (r >> 2); if (kk > qrel) s0[r] = -1e30f; if (kk + 32 > qrel) s1[r] = -1e30f; }
            }
            float mx = fmaxf(s0[0], s1[0]);
#pragma unroll
            for (int r = 1; r < 16; ++r) mx = fmaxf(mx, fmaxf(s0[r], s1[r]));
            { auto rr = __builtin_amdgcn_permlane32_swap(__float_as_uint(mx), __float_as_uint(mx), false, false); mx = fmaxf(__uint_as_float(rr[0]), __uint_as_float(rr[1])); }
            const bool need = (j == jsw) || (mx > THR);
            if (__any(need)) {
                const float delta = need ? mx : 0.f;
                const float alpha = (j == jsw) ? 1.f : __builtin_amdgcn_exp2f(-delta);
                lrun *= alpha;
#pragma unroll
                for (int r = 0; r < 16; ++r) { s0[r] -= delta; s1[r] -= delta; negc[r] -= delta; }
#pragma unroll
                for (int e = 0; e < 4; ++e)
#pragma unroll
                    for (int r = 0; r < 16; ++r) acc[e][r] *= alpha;
            }
            float ps = 0.f;
#pragma unroll
            for (int r = 0; r < 16; ++r) { s0[r] = __builtin_amdgcn_exp2f(s0[r]); s1[r] = __builtin_amdgcn_exp2f(s1[r]); ps += s0[r] + s1[r]; }
            lrun += ps;
            bf16x8 pf[4];
#pragma unroll
            for (int s = 0; s < 4; ++s) {
                u32x4 w;
                if (s < 2) { const int o = 8 * s; w.x = cvtpk(s0[o], s0[o + 1]); w.y = cvtpk(s0[o + 2], s0[o + 3]); w.z = cvtpk(s0[o + 4], s0[o + 5]); w.w = cvtpk(s0[o + 6], s0[o + 7]); }
                else { const int o = 8 * (s - 2); w.x = cvtpk(s1[o], s1[o + 1]); w.y = cvtpk(s1[o + 2], s1[o + 3]); w.z = cvtpk(s1[o + 4], s1[o + 5]); w.w = cvtpk(s1[o + 6], s1[o + 7]); }
                pf[s] = __builtin_bit_cast(bf16x8, w);
            }
#pragma unroll
            for (int s = 0; s < 4; ++s) {
#pragma unroll
                for (int e = 0; e < 4; ++e) {
                    const s16x4 lo = vtr(Vc + s * 4096 + e * 512), hv = vtr(Vc + s * 4096 + e * 512 + 2048);
                    const bf16x8 vf = (bf16x8){lo[0], lo[1], lo[2], lo[3], hv[0], hv[1], hv[2], hv[3]};
                    acc[e] = __builtin_amdgcn_mfma_f32_32x32x16_bf16(vf, pf[s], acc[e], 0, 0, 0);
                }
            }
        }
        if (j + 1 < NT) { const int nx = cur ^ 1; *(LAS u32x4*)(Kl + nx * 2 * AK_BYTES + kdst[0]) = kreg[0]; *(LAS u32x4*)(Kl + nx * 2 * AK_BYTES + kdst[1]) = kreg[1];
                          *(LAS u32x4*)(Vl + nx * AV_BYTES + vdst[0]) = vreg[0]; *(LAS u32x4*)(Vl + nx * AV_BYTES + vdst[1]) = vreg[1]; }
        __syncthreads();
    }
    { auto rr = __builtin_amdgcn_permlane32_swap(__float_as_uint(lrun), __float_as_uint(lrun), false, false); lrun = __uint_as_float(rr[0]) + __uint_as_float(rr[1]); }
    {
        const float inv = 1.f / lrun;
        LAS unsigned* stash = (LAS unsigned*)(lds + A_STASH) + w4 * 64 + lane;
        if (jc == 0) {
#pragma unroll
            for (int e = 0; e < 4; ++e)
#pragma unroll
                for (int i = 0; i < 8; ++i) stash[(e * 8 + i) * 256] = cvtpk(acc[e][2 * i] * inv, acc[e][2 * i + 1] * inv);
        }
        __syncthreads();
        if (jc == 1) {
            float ss = 0.f;
#pragma unroll
            for (int e = 0; e < 4; ++e)
#pragma unroll
                for (int i = 0; i < 8; ++i) { const unsigned w = stash[(e * 8 + i) * 256];
                    const float o0 = bflo(w) - lam * (acc[e][2 * i] * inv), o1 = bfhi(w) - lam * (acc[e][2 * i + 1] * inv);
                    acc[e][2 * i] = o0; acc[e][2 * i + 1] = o1; ss += o0 * o0 + o1 * o1; }
            { auto rr = __builtin_amdgcn_permlane32_swap(__float_as_uint(ss), __float_as_uint(ss), false, false); ss = __uint_as_float(rr[0]) + __uint_as_float(rr[1]); }
            const float rn = __builtin_amdgcn_rsqf(ss * (1.f / 128.f) + EPS) * 0.8f;
            if (tq >= 0 && jmax >= 0) {
                const int orow = tq < NMETA ? MAINR + tq : b * SEQ + tq - NMETA;
                bf16* op = YATT + (size_t)orow * 512 + h * 128 + 4 * hi;
#pragma unroll
                for (int e = 0; e < 4; ++e)
#pragma unroll
                    for (int i = 0; i < 4; ++i) { const f32x4 g = *(const f32x4*)(sg + 32 * e + 8 * i + 4 * hi);
                        u32x2 w; w.x = cvtpk(acc[e][4 * i] * rn * g[0], acc[e][4 * i + 1] * rn * g[1]); w.y = cvtpk(acc[e][4 * i + 2] * rn * g[2], acc[e][4 * i + 3] * rn * g[3]); *(u32x2*)(op + 32 * e + 8 * i) = w; }
            }
        }
        __syncthreads();
    }
}

__device__ __forceinline__ void ssm_scan(const float* __restrict__ EB, const float* __restrict__ LAM16, bf16* __restrict__ UM, int pair, int lane) {
    const int b = pair >> 5, g = pair & 31, p = lane;
    const float lr = LAM16[(g * 64 + p) * 2], li = LAM16[(g * 64 + p) * 2 + 1];
    float sr = 0.f, si = 0.f;
    const size_t row0 = (size_t)g * NCP + (size_t)b * NCHK;
    float er[8], ei[8], nr_[8], ni_[8];
#pragma unroll
    for (int k = 0; k < 8; ++k) { er[k] = EB[(row0 + k) * 128 + p]; ei[k] = EB[(row0 + k) * 128 + 64 + p]; }
    for (int c0 = 0; c0 < NCHK; c0 += 8) {
#pragma unroll
        for (int k = 0; k < 8; ++k) { const int c = c0 + 8 + k < NCHK ? c0 + 8 + k : NCHK - 1; nr_[k] = EB[(row0 + c) * 128 + p]; ni_[k] = EB[(row0 + c) * 128 + 64 + p]; }
#pragma unroll
        for (int k = 0; k < 8; ++k) if (c0 + k < NCHK) {
            bf16* up = UM + (row0 + c0 + k) * UMK + 256 + p; up[0] = f2bf(sr); up[64] = f2bf(si);
            const float nr = lr * sr - li * si + er[k], ni = lr * si + li * sr + ei[k]; sr = nr; si = ni;
        }
#pragma unroll
        for (int k = 0; k < 8; ++k) { er[k] = nr_[k]; ei[k] = ni_[k]; }
    }
}

__device__ __forceinline__ void tr_item(const float* __restrict__ W, int ldw, int K, bf16* __restrict__ WT, int nblk, int mapmode, const float* __restrict__ ksc, LAS float* scr, int item, int lane) {
    const int kb = item / nblk, nb = item - kb * nblk, k0 = 64 * kb, n0 = 32 * nb;
    const int L = (n0 & ~255) + 64 * ((n0 >> 5) & 3) + 32 * ((n0 >> 7) & 1);
    const int src0 = mapmode ? ((L >> 5) & 1) * DFF + 128 * (L >> 8) + 32 * ((L >> 6) & 3) : L;
    f32x4 v[8];
#pragma unroll
    for (int i = 0; i < 8; ++i) { const int kk = 8 * i + (lane >> 3); v[i] = __builtin_nontemporal_load((const f32x4*)(W + (size_t)(k0 + kk) * ldw + src0 + 4 * (lane & 7))); }
#pragma unroll
    for (int i = 0; i < 8; ++i) { const int kk = 8 * i + (lane >> 3); f32x4 w = v[i]; if (ksc) w *= ksc[k0 + kk];
        LAS float* d = scr + kk * 33 + 4 * (lane & 7); d[0] = w[0]; d[1] = w[1]; d[2] = w[2]; d[3] = w[3]; }
    asm volatile("s_waitcnt lgkmcnt(0)" ::: "memory");
    const int c = lane & 7;
#pragma unroll
    for (int j = 0; j < 4; ++j) { const int n = (lane >> 3) + 8 * j; const LAS float* s = scr + (8 * c) * 33 + n;
        u32x4 o; o.x = cvtpk(s[0 * 33], s[1 * 33]); o.y = cvtpk(s[2 * 33], s[3 * 33]); o.z = cvtpk(s[4 * 33], s[5 * 33]); o.w = cvtpk(s[6 * 33], s[7 * 33]);
        *(u32x4*)(WT + (size_t)(n0 + n) * K + k0 + 8 * c) = o; }
    asm volatile("s_waitcnt lgkmcnt(0)" ::: "memory");
}
template <int NR> __device__ __forceinline__ void rows_to_bf16(const float* const* src, bf16* const* dst, float* const* r1, int lane) {
    f32x4 v[NR][4];
#pragma unroll
    for (int r = 0; r < NR; ++r)
#pragma unroll
        for (int j = 0; j < 4; ++j) v[r][j] = __builtin_nontemporal_load((const f32x4*)src[r] + lane + 64 * j);
#pragma unroll
    for (int r = 0; r < NR; ++r) {
        float s = 0.f;
#pragma unroll
        for (int j = 0; j < 4; ++j) s += sq4(v[r][j]);
        s = wave_sum(s);
        if (lane == 0) *r1[r] = __builtin_amdgcn_rsqf(s * (1.f / 1024.f) + EPS);
        u32x2* o8 = (u32x2*)dst[r] + lane;
#pragma unroll
        for (int j = 0; j < 4; ++j) { u32x2 w; w.x = cvtpk(v[r][j][0], v[r][j][1]); w.y = cvtpk(v[r][j][2], v[r][j][3]); o8[64 * j] = w; }
    }
}
__device__ __forceinline__ void ssm_tables(int g, int part, LAS float* L, bf16* __restrict__ TE, bf16* __restrict__ FT, float* __restrict__ LAM16) {
    const int tid = threadIdx.x;
    LAS float* lkr = L;
    LAS float* lki = L + 17 * 64;
    LAS float* fr_ = L + 34 * 64;
    LAS float* fi_ = fr_ + 64;
    LAS float* Bbr = fi_ + 64;
    LAS float* Bbi = Bbr + 1024;
    LAS float* Cr = Bbi + 1024;
    LAS float* Ci = Cr + 1024;
    LAS float* Kt = Ci + 1024;
    const float dt = __expf(INP(6)[g]);
    if (tid < 64) {
        const int p = tid; const float are = INP(4)[g * 64 + p], aim = INP(5)[g * 64 + p];
        for (int k = 0; k <= 16; ++k) {
            const float mag = __expf(are * dt * (float)k);
            float rev = aim * dt * (float)k * 0.15915494309189535f; rev -= rintf(rev);
            lkr[k * 64 + p] = mag * __builtin_amdgcn_cosf(rev); lki[k * 64 + p] = mag * __builtin_amdgcn_sinf(rev);
        }
        const float lbr = lkr[64 + p], lbi = lki[64 + p], den = are * are + aim * aim, nre = lbr - 1.f;
        fr_[p] = (nre * are + lbi * aim) / den; fi_[p] = (lbi * are - nre * aim) / den;
        if (part == 0) { LAM16[(g * 64 + p) * 2] = lkr[16 * 64 + p]; LAM16[(g * 64 + p) * 2 + 1] = lki[16 * 64 + p]; }
    }
    __syncthreads();
    for (int i = tid; i < 1024; i += 512) {
        const int p = i >> 4; const float br = INP(7)[g * 1024 + i], bi = INP(8)[g * 1024 + i];
        Bbr[i] = fr_[p] * br - fi_[p] * bi; Bbi[i] = fr_[p] * bi + fi_[p] * br;
        Cr[i] = INP(9)[g * 1024 + i]; Ci[i] = INP(10)[g * 1024 + i];
    }
    __syncthreads();
    {
        const int k = tid >> 5, cl = (tid >> 4) & 1, c = 2 * part + cl, c2 = tid & 15; float s = 0.f;
        for (int p = 0; p < 64; ++p) {
            const float cr = Cr[c * 64 + p], ci = Ci[c * 64 + p], lr = lkr[k * 64 + p], li = lki[k * 64 + p];
            const float xr = cr * lr - ci * li, xi = cr * li + ci * lr;
            s += xr * Bbr[p * 16 + c2] - xi * Bbi[p * 16 + c2];
        }
        if (k == 0 && c == c2) s += INP(11)[g * 16 + c];
        Kt[tid] = s;
    }
    __syncthreads();
    for (int i = tid; i < 32 * 192; i += 512) {
        const int rr = i / 192, k = (i - rr * 192) * 2, t = rr >> 1, cl = rr & 1, c = 2 * part + cl;
        const int Lc = t * 16 + c, n = 128 * ((Lc >> 5) & 1) + 32 * (Lc >> 6) + (Lc & 31);
        float v[2];
#pragma unroll
        for (int q = 0; q < 2; ++q) { const int kk = k + q;
            if (kk < 256) { const int t2 = kk >> 4, c2 = kk & 15; v[q] = t >= t2 ? Kt[((t - t2) * 2 + cl) * 16 + c2] : 0.f; }
            else { const int p = (kk - 256) & 63; const float cr = Cr[c * 64 + p], ci = Ci[c * 64 + p], lr = lkr[(t + 1) * 64 + p], li = lki[(t + 1) * 64 + p];
                   v[q] = kk < 320 ? cr * lr - ci * li : -(cr * li + ci * lr); } }
        *(unsigned*)(TE + (size_t)(g * 256 + n) * UMK + k) = cvtpk(v[0], v[1]);
    }
    for (int i = tid; i < 32 * 128; i += 512) {
        const int rr = i >> 7, k = (i & 127) * 2, s = (rr < 16 ? 0 : 128) + 16 * part + (rr & 15);
        const int n = 128 * ((s >> 5) & 1) + 32 * (s >> 6) + (s & 31);
        float v[2] = {0.f, 0.f};
        if (s < 128) { const int p = s & 63;
#pragma unroll
            for (int q = 0; q < 2; ++q) { const int kk = k + q, jj = kk >> 4, c2 = kk & 15; const float lr = lkr[(15 - jj) * 64 + p], li = lki[(15 - jj) * 64 + p], br = Bbr[p * 16 + c2], bi = Bbi[p * 16 + c2];
                v[q] = s < 64 ? lr * br - li * bi : lr * bi + li * br; } }
        *(unsigned*)(FT + (size_t)(g * 256 + n) * 256 + k) = cvtpk(v[0], v[1]);
    }
    __syncthreads();
}

constexpr int NPHASE = 11;
#define R1 ((float*)(WSP() + WS_R1))
#define SS2 ((float*)(WSP() + WS_SS2))
#define H1M ((float*)(WSP() + WS_H1M))
#define LAM16 ((float*)(WSP() + WS_LAM16))
#define AM ((float*)(WSP() + WS_AM))
#define WIN ((bf16*)(WSP() + WS_WIN))
#define WGLU ((bf16*)(WSP() + WS_WGLU))
#define WSO ((bf16*)(WSP() + WS_WSO))
#define WAO ((bf16*)(WSP() + WS_WAO))
#define WO ((bf16*)(WSP() + WS_WO))
#define WUP ((bf16*)(WSP() + WS_WUP))
#define WDN ((bf16*)(WSP() + WS_WDN))
#define TE ((bf16*)(WSP() + WS_TE))
#define FT ((bf16*)(WSP() + WS_F))
#define CP ((float*)(WSP() + WS_CP))
#define BP ((float*)(WSP() + WS_BP))
#define AT ((float*)(WSP() + WS_AT))
#define XB ((bf16*)(WSP() + WS_XB))
#define MIX ((bf16*)(WSP() + WS_MIX))
#define UM ((bf16*)(WSP() + WS_UM))
#define H1B ((bf16*)(WSP() + WS_H1B))
#define QB ((bf16*)(WSP() + WS_QB))
#define KB ((bf16*)(WSP() + WS_KB))
#define VB ((bf16*)(WSP() + WS_VB))
#define YSS ((bf16*)(WSP() + WS_YSS))
#define PATT ((bf16*)(WSP() + WS_PATT))
#define GSA ((bf16*)(WSP() + WS_GSA))
#define EB ((float*)(WSP() + WS_EB))
#define YATT ((bf16*)(WSP() + WS_YATT))
#define YG ((bf16*)(WSP() + WS_YG))
#define ACT ((bf16*)(WSP() + WS_ACT))
__global__ void __launch_bounds__(NWAVES * 64, 2) hybrid_fwd(Params P) {
    extern __shared__ __attribute__((aligned(16))) unsigned char lds_raw[];
    LAS unsigned char* lds = (LAS unsigned char*)lds_raw;
    const int tid = threadIdx.x, lane = tid & 63, wave = __builtin_amdgcn_readfirstlane(tid >> 6);
    const int G = gridDim.x, bx = blockIdx.x;
    const int vcu = (G % 8 == 0) ? (bx % 8) * (G / 8) + bx / 8 : bx;
    const int gw = bx * NWAVES + wave, NGW = G * NWAVES;
    const int lo = P.ph_lo, hi = P.ph_hi;
    if (tid < 64) ((LAS unsigned*)(lds + LDS_X))[tid] = 0u;
    __syncthreads();
    XcdBarrier xbar = xcd_barrier_post((unsigned*)(WSP() + WS_BAR), (volatile LAS unsigned*)(lds + LDS_X));
#define IN(k) (lo <= (k) && (k) < hi)
#define SEAM(k) do { if (IN(k) && IN((k) + 1)) { if (hi > 1000) cg::this_grid().sync(); else xcd_barrier(xbar); } } while (0)

    if (IN(0)) {
        for (int v = bx; v < NG * 8; v += G) ssm_tables(v >> 3, v & 7, (LAS float*)lds, TE, FT, LAM16);
        LAS float* scr = (LAS float*)(lds + wave * 16384);
        for (int it = gw; it < 16 * 128; it += NGW) tr_item(INP(3), INC, 1024, WIN, 128, 0, INP(2), scr, it, lane);
        for (int i = bx * 512 + tid; i < RP; i += G * 512) SS2[i] = 0.f;
        for (int m0 = gw * 4; m0 < MAINR + NMETA; m0 += NGW * 4) {
            const float* src[4]; bf16* dst[4]; float* rr[4];
#pragma unroll
            for (int r = 0; r < 4; ++r) { const int m = m0 + r; src[r] = m < MAINR ? INP(0) + (size_t)m * 1024 : INP(1) + (size_t)(m - MAINR) * 1024; dst[r] = XB + (size_t)m * 1024; rr[r] = R1 + m; }
            rows_to_bf16<4>(src, dst, rr, lane);
        }
        for (int i = bx * 512 + tid; i < (RP - CROWS) * 512 / 8; i += G * 512) { ((u32x4*)(KB + (size_t)CROWS * 512))[i] = (u32x4){0u, 0u, 0u, 0u}; ((u32x4*)(VB + (size_t)CROWS * 512))[i] = (u32x4){0u, 0u, 0u, 0u}; }
        __syncthreads();
    }
    SEAM(0);
    if (IN(1)) {
        EpiG<FIn> E{FIn{R1, UM, QB, KB, VB, GSA, INP(14), INP(15)}};
        skinny16(XB + (size_t)MAINR * 1024, 1024, WIN, 1024, INC, 1024, bx, G, lane, wave, (LAS float*)lds, E.f);
        pg8::Gemm g{XB, WIN, MAINR, INC, 1024, 1024, 1024}; pg8::StaticOrder S; S.init(MAINR, INC, G, bx);
        pg8::gemm_phase<EpiG<FIn>, pg8::StaticOrder, true, true>(lds, g, S, E);
    }
    SEAM(1);
    if (IN(2)) {
        EpiG<FE> E{FE{EB}};
        skinny_ssm(UM, FT, 256, 256, bx, G, lane, wave, (LAS float*)lds, E.f);
        pg8::Gemm g{UM, FT, NG * NCP, NG * 256, 256, UMK, 256}; SsmOrder S{G, bx};
        pg8::gemm_phase<EpiG<FE>, SsmOrder, true, true>(lds, g, S, E);
    }
    SEAM(2);
    if (IN(3)) {
        const int nscan = G >= 64 ? 32 : G;
        if (bx < nscan) { for (int v = bx * NWAVES + wave; v < NBATCH * NG; v += nscan * NWAVES) ssm_scan(EB, LAM16, UM, v, lane); }
        if (bx >= nscan || nscan == G) {
            LAS float* scr = (LAS float*)(lds + wave * 16384);
            constexpr int I_GLU = 8 * 16, I_SO = 8 * 32, I_AO = 8 * 32, I_WO = 16 * 32, I_UP = 16 * 176, I_DN = 44 * 32;
            constexpr int NITEMS = I_GLU + I_SO + I_AO + I_WO + I_UP + I_DN;
            const int tw0 = nscan == G ? gw : (bx - nscan) * NWAVES + wave, tnw = nscan == G ? NGW : (G - nscan) * NWAVES;
            for (int it = tw0; it < NITEMS; it += tnw) {
                int r = it;
                if (r < I_GLU) { tr_item(INP(12), 512, 512, WGLU, 16, 0, nullptr, scr, r, lane); continue; } r -= I_GLU;
                if (r < I_SO) { tr_item(INP(21), 1024, 512, WSO, 32, 0, nullptr, scr, r, lane); continue; } r -= I_SO;
                if (r < I_AO) { tr_item(INP(22), 1024, 512, WAO, 32, 0, nullptr, scr, r, lane); continue; } r -= I_AO;
                if (r < I_WO) { tr_item(INP(23), 1024, 1024, WO, 32, 0, nullptr, scr, r, lane); continue; } r -= I_WO;
                if (r < I_UP) { tr_item(INP(25), UPC, 1024, WUP, 176, 1, INP(24), scr, r, lane); continue; } r -= I_UP;
                tr_item(INP(28), 1024, DFF, WDN, 32, 0, nullptr, scr, r, lane);
            }
        }
        const float gqm = fabsf(INP(14)[lane]), gkm = fabsf(INP(15)[lane]);
        float gq = gqm, gk = gkm;
#pragma unroll
        for (int o = 1; o < 64; o <<= 1) { gq = fmaxf(gq, __shfl_xor(gq, o)); gk = fmaxf(gk, __shfl_xor(gk, o)); }
        const float Rb = 2.2f * 8.f * gq * gk + 110.f;
        volatile LAS int* qw = (volatile LAS int*)(lds + LDS_X + 512);
        unsigned* qctr = (unsigned*)(WSP() + WS_BAR) + 4000;
        const float lam = __expf(wave_sum(INP(16)[lane] * INP(17)[lane])) - __expf(wave_sum(INP(18)[lane] * INP(19)[lane])) + 0.2f;
        for (;;) {
            if (tid == 0) *qw = (int)atomicAdd(qctr, 1u);
            __syncthreads();
            const int id = *qw;
            __syncthreads();
            if (id >= 1024 + 4) break;
            int b, h, q0, js, nt, D = 8192;
            if (id >= 1024) { b = 0; h = id - 1024; q0 = -112; js = 0; nt = 1; }
            else { const int hb = 31 - (id >> 5), bh = id & 31; b = bh >> 2; h = bh & 3; q0 = 16 + 128 * hb; nt = ((q0 + 127) >> 6) + 1;
                   const float Df = Rb * (float)(4 << (2 * h));
                   D = Df > 8192.f ? 8192 : (int)Df; js = q0 - D > 0 ? (q0 - D) >> 6 : 0; }
            attn_unit(QB, KB, VB, YATT, INP(20), lam, b, h, q0, js, D, nt, lds);
        }
    }
    SEAM(3);
    if (IN(4)) {
        EpiG<FY> E{FY{YG}};
        skinny_ssm(UM, TE, UMK, UMK, bx, G, lane, wave, (LAS float*)lds, E.f);
        pg8::Gemm g{UM, TE, NG * NCP, NG * 256, UMK, UMK, UMK}; SsmOrder S{G, bx};
        pg8::gemm_phase<EpiG<FY>, SsmOrder, true, true>(lds, g, S, E);
    }
    SEAM(4);
    if (IN(5)) {
        EpiG<FGlu> E1{FGlu{YG, YSS, INP(13)}}; EpiG<FPatt> E2{FPatt{GSA, PATT}};
        skinny16(YG + (size_t)MAINR * 512, 512, WGLU, 512, 512, 512, bx, G, lane, wave, (LAS float*)lds, E1.f);
        skinny16(YATT + (size_t)MAINR * 512, 512, WAO, 512, 1024, 512, bx, G, lane, wave, (LAS float*)lds, E2.f, 8);
        { pg8::Gemm g{YG, WGLU, MAINR, 512, 512, 512, 512}; pg8::StaticOrder S; S.init(MAINR, 512, G, bx); pg8::gemm_phase<EpiG<FGlu>, pg8::StaticOrder, true, true>(lds, g, S, E1); }
        { pg8::Gemm g{YATT, WAO, MAINR, 1024, 512, 512, 512}; pg8::StaticOrder S; S.init(MAINR, 1024, G, bx); pg8::gemm_phase<EpiG<FPatt>, pg8::StaticOrder, true, true>(lds, g, S, E2); }
    }
    SEAM(5);
    if (IN(6)) {
        EpiG<FMix> E{FMix{GSA, PATT, MIX}};
        skinny16(YSS + (size_t)MAINR * 512, 512, WSO, 512, 1024, 512, bx, G, lane, wave, (LAS float*)lds, E.f);
        pg8::Gemm g{YSS, WSO, MAINR, 1024, 512, 512, 512}; pg8::StaticOrder S; S.init(MAINR, 1024, G, bx);
        pg8::gemm_phase<EpiG<FMix>, pg8::StaticOrder, true, true>(lds, g, S, E);
    }
    SEAM(6);
    if (IN(7)) {
        EpiG<FWo> E{FWo{XB, H1B, SS2}};
        skinny16(MIX + (size_t)MAINR * 1024, 1024, WO, 1024, 1024, 1024, bx, G, lane, wave, (LAS float*)lds, E.f);
        pg8::Gemm g{MIX, WO, MAINR, 1024, 1024, 1024, 1024}; pg8::StaticOrder S; S.init(MAINR, 1024, G, bx);
        pg8::gemm_phase<EpiG<FWo>, pg8::StaticOrder, true, true>(lds, g, S, E);
    }
    SEAM(7);
    if (IN(8)) {
        FUpMeta fm{SS2, AM};
        skinny16(H1B + (size_t)MAINR * 1024, 1024, WUP, 1024, UPC, 1024, bx, G, lane, wave, (LAS float*)lds, fm);
        EpiUp E{SS2, INP(26), INP(27), ACT, CP, BP, AT, (LAS float*)(lds + LDS_X + 1024)};
        pg8::Gemm g{H1B, WUP, MAINR, UPC, 1024, 1024, 1024}; pg8::StaticOrder S; S.init(MAINR, UPC, G, bx);
        pg8::gemm_phase<EpiUp, pg8::StaticOrder, true, true>(lds, g, S, E);
    }
    do { if (IN(8) && IN(10)) xcd_barrier(xbar); } while (0);
    if (IN(10)) {
        pg8::StaticOrder S; S.init(MAINR, 1024, G, bx);
        {
            const float* cw = INP(26); pg8::Unit uu; int lastpm = -1;
            for (int ui = 0; S.next(ui, uu); ++ui) {
                const int pm = uu.pm; if (pm == lastpm) continue; lastpm = pm;
                for (int i = tid; i < 2 * (DFF / 4); i += 512) {
                    const int q = i % (DFF / 4), row = i / (DFF / 4), pr = pm * 2 + row, hid = 4 * q;
                    const float* a2p = (pm & 15) == 0 ? AM + hid : AT + (size_t)((pm - 1) * 2) * DFF + hid;
                    const f32x4 am2 = *(const f32x4*)a2p, am1 = *(const f32x4*)(a2p + DFF);
                    const f32x4 w0 = *(const f32x4*)(cw + hid), w1 = *(const f32x4*)(cw + DFF + hid);
                    f32x4 c = *(const f32x4*)(CP + (size_t)pr * DFF + hid); const f32x4 bg = *(const f32x4*)(BP + (size_t)pr * DFF + hid);
                    if (row == 0) c += w1 * am1 + w0 * am2; else c += w0 * am1;
                    const f32x4 o = gelu4(c) * bg;
                    u32x2 w; w.x = cvtpk(o[0], o[1]); w.y = cvtpk(o[2], o[3]);
                    *(u32x2*)(ACT + (size_t)(pm * 256 + row) * DFF + hid) = w;
                }
            }
            asm volatile("s_waitcnt vmcnt(0)" ::: "memory"); __syncthreads();
        }
        EpiG<FDown> E{FDown{H1B, OUTP()}};
        pg8::Gemm g{ACT, WDN, MAINR, 1024, DFF, DFF, DFF};
        pg8::gemm_phase<EpiG<FDown>, pg8::StaticOrder, true, true>(lds, g, S, E);
    }
#undef IN
#undef SEAM
}
#undef R1
#undef SS2
#undef H1M
#undef LAM16
#undef AM
#undef WIN
#undef WGLU
#undef WSO
#undef WAO
#undef WO
#undef WUP
#undef WDN
#undef TE
#undef FT
#undef CP
#undef BP
#undef AT
#undef XB
#undef MIX
#undef UM
#undef H1B
#undef QB
#undef KB
#undef VB
#undef YSS
#undef PATT
#undef GSA
#undef EB
#undef YATT
#undef YG
#undef ACT

extern "C" void kernel_launch(void* const* d_in, const int* in_sizes, int n_in, void* d_out, int out_size, void* d_ws, size_t ws_size, hipStream_t stream) {
    static int grid = 0;
    if (grid == 0) {
        if (n_in != 29 || ws_size < WS_END) { fprintf(stderr, "kernel_launch: unexpected n_in %d or ws_size %zu (need %zu)\n", n_in, ws_size, (size_t)WS_END); grid = -1; return; }
        int dev = 0, cus = 0, per_cu = 0;
        (void)hipGetDevice(&dev); (void)hipDeviceGetAttribute(&cus, hipDeviceAttributeMultiprocessorCount, dev);
        if (hipFuncSetAttribute((const void*)hybrid_fwd, hipFuncAttributeMaxDynamicSharedMemorySize, LDS_BYTES) != hipSuccess) { fprintf(stderr, "kernel_launch: hipFuncSetAttribute failed\n"); grid = -1; return; }
        if (hipOccupancyMaxActiveBlocksPerMultiprocessor(&per_cu, (const void*)hybrid_fwd, NWAVES * 64, LDS_BYTES) != hipSuccess || per_cu < 1) { fprintf(stderr, "kernel_launch: occupancy query says %d\n", per_cu); per_cu = 1; }
        (void)hipGetLastError();
        grid = cus * 1;
        if (grid != 256) fprintf(stderr, "kernel_launch: note: %d CUs\n", grid);
    }
    if (grid < 0) return;
    if (hipMemsetAsync((char*)d_ws + WS_BAR, 0, 16384, stream) != hipSuccess) { fprintf(stderr, "kernel_launch: memset failed\n"); return; }
    Params p{};
    for (int i = 0; i < 29; ++i) p.in[i] = (const float*)d_in[i];
    p.out = (float*)d_out; p.ws = (unsigned char*)d_ws;
    p.ph_lo = 0; p.ph_hi = NPHASE;
    void* args[] = {&p};
    hipError_t e = hipLaunchCooperativeKernel((const void*)hybrid_fwd, dim3(grid), dim3(NWAVES * 64), args, LDS_BYTES, stream);
    if (e != hipSuccess) fprintf(stderr, "cooperative launch failed: %s (grid %d)\n", hipGetErrorString(e), grid);
}
```

```cpp
#include <hip/hip_runtime.h>
#include <hip/hip_cooperative_groups.h>
#include <cstdio>
#include <cstdint>
namespace cg = cooperative_groups;

namespace pg8 {
#define PG8_LAS __attribute__((address_space(3)))
typedef unsigned short bf16_t;
typedef short bf16x8 __attribute__((ext_vector_type(8)));
typedef float f32x4 __attribute__((ext_vector_type(4)));
typedef unsigned u32x4 __attribute__((ext_vector_type(4)));
constexpr int BM = 256, BK = 64, HALF = 128, HTB = HALF * BK * 2  , STAGE_BYTES = 8 * HTB, NXCD = 8, WGM = 2;

__host__ __device__ __forceinline__ int lds_byte(int r, int c) { const int st = (r >> 4) * 2 + (c >> 5), rr = r & 15, cc = c & 31, ob = rr * 64 + cc * 2; return st * 1024 + (ob ^ (((ob >> 9) & 1) << 5)); }
__host__ __device__ __forceinline__ void stage_rc(int b, int& R, int& C) { const int st = b / 1024, sb = b % 1024, swz = sb ^ (((sb >> 9) & 1) << 5); R = (st >> 1) * 16 + swz / 64; C = (st & 1) * 32 + (swz % 64) / 2; }
__host__ __device__ __forceinline__ int perm32(int rho) { const int n = rho >> 4, i = rho & 15; return 8 * (i >> 2) + 4 * n + (i & 3); }

struct Unit { int pm, pn; };
struct Gemm { const bf16_t* A; const bf16_t* Bt; int M, N, K, lda, ldb; };

struct StaticOrder {
    int nM, nN, nwg, G, c;
    __host__ __device__ void init(int M, int N, int G_, int c_) { nM = M / BM; nN = N / BM; nwg = nM * nN; G = G_; c = c_; }
    __host__ __device__ bool next(int i, Unit& u) const {
        const long L = (long)i * G + c; if (L >= nwg) return false;
        int wgid = (int)L; { const int q = nwg / NXCD, r = nwg % NXCD, xcd = wgid % NXCD, off = wgid / NXCD; wgid = (xcd < r ? xcd * (q + 1) : r * (q + 1) + (xcd - r) * q) + off; }
        const int nig = WGM * nN, gid = wgid / nig, fm = gid * WGM, gsz = (nM - fm) < WGM ? (nM - fm) : WGM;
        u.pm = fm + ((wgid % nig) % gsz); u.pn = (wgid % nig) / gsz; return true;
    }
    __device__ __forceinline__ void a_ready(const Unit&) const {}
    __device__ __forceinline__ void done(const Unit&) const {}
};
template <class Epi, class Sched, bool ALIGN_EPI = false, bool SP2 = false>
__device__ __forceinline__ void gemm_phase(PG8_LAS unsigned char* lds, const Gemm g, const Sched& S, const Epi& E) {
    int tid_ = threadIdx.x; asm volatile("" : "+v"(tid_));
    const int tid = tid_, wid = __builtin_amdgcn_readfirstlane(tid >> 6), lane = tid & 63, wr = wid >> 2, wc = wid & 3, fr = lane & 15, fq = lane >> 4;
    const int K = g.K, nt = K / BK;
    unsigned voffA[2], voffB[2];
#pragma unroll
    for (int i = 0; i < 2; ++i) { int R, C; stage_rc(tid * 16 + i * 8192, R, C); const int Rb = Epi::PERM ? ((R & ~31) + perm32(R & 31)) : R;
        voffA[i] = (unsigned)(R * g.lda + C) * 2u; voffB[i] = (unsigned)(Rb * g.ldb + C) * 2u; }
    const size_t kstep = (size_t)(BK * 2);
    const size_t hstepA = (size_t)HALF * g.lda * 2, hstepB = (size_t)HALF * g.ldb * 2;
    const size_t tstepA = 2 * hstepA, tstepB = 2 * hstepB;
    const unsigned ldsw = (unsigned)wid * 1024u;
    const int aoff = lds_byte(wr * 64 + fr, fq * 8), boff = lds_byte(wc * 32 + fr, fq * 8);
#define PG8_SA(b, h) (((b) * 2 + (h)) * HTB)
#define PG8_SB(b, h) ((4 + (b) * 2 + (h)) * HTB)
#define PG8_STAGE(bufoff, gbase, voff) do { _Pragma("unroll") for (int _i = 0; _i < 2; ++_i) \
        __builtin_amdgcn_global_load_lds((const unsigned*)((const char*)(gbase) + (voff)[_i]), (PG8_LAS unsigned*)(lds + (bufoff) + ldsw + _i * 8192), 16, 0, 0); } while (0)
#define PG8_LDA(dst, b, h) do { _Pragma("unroll") for (int m = 0; m < 4; ++m) _Pragma("unroll") for (int k = 0; k < 2; ++k) dst[m][k] = *(const PG8_LAS bf16x8*)(lds + PG8_SA(b, h) + aoff + m * 2048 + k * 1024); } while (0)
#define PG8_LDB(dst, b, h) do { _Pragma("unroll") for (int n = 0; n < 2; ++n) _Pragma("unroll") for (int k = 0; k < 2; ++k) dst[n][k] = *(const PG8_LAS bf16x8*)(lds + PG8_SB(b, h) + boff + n * 2048 + k * 1024); } while (0)
#define PG8_MMA(ai, bj, At, Bt) do { __builtin_amdgcn_s_setprio(1); _Pragma("unroll") for (int m = 0; m < 4; ++m) _Pragma("unroll") for (int n = 0; n < 2; ++n) _Pragma("unroll") for (int k = 0; k < 2; ++k) \
        acc[ai][bj][m][n] = __builtin_amdgcn_mfma_f32_16x16x32_bf16(Bt[n][k], At[m][k], acc[ai][bj][m][n], 0, 0, 0); __builtin_amdgcn_s_setprio(0); } while (0)
#define PG8_WAIT_V(n) asm volatile("s_waitcnt vmcnt(" #n ")" ::: "memory")
#define PG8_WAIT_L(n) asm volatile("s_waitcnt lgkmcnt(" #n ")" ::: "memory")
#define PG8_BAR __builtin_amdgcn_s_barrier()
#define PG8_SCHED __builtin_amdgcn_sched_barrier(0)
    Unit cur, nxt; int ui = 0;
    if (!S.next(0, cur)) return;
    f32x4 acc[2][2][4][2];
#pragma unroll
    for (int a = 0; a < 2; ++a)
#pragma unroll
        for (int b = 0; b < 2; ++b)
#pragma unroll
            for (int m = 0; m < 4; ++m)
#pragma unroll
                for (int n = 0; n < 2; ++n) acc[a][b][m][n] = (f32x4){0.f, 0.f, 0.f, 0.f};
    bf16x8 At[4][2], B0[2][2], B1[2][2];
    const char* cA = (const char*)g.A + (size_t)cur.pm * tstepA; const char* cB = (const char*)g.Bt + (size_t)cur.pn * tstepB;
    S.a_ready(cur);
    if constexpr (SP2) {
        PG8_STAGE(PG8_SB(0, 0), cB, voffB); PG8_STAGE(PG8_SB(0, 1), cB + hstepB, voffB); PG8_STAGE(PG8_SA(0, 0), cA, voffA); PG8_STAGE(PG8_SA(0, 1), cA + hstepA, voffA);
        if (wr == 1) PG8_BAR;
        PG8_WAIT_V(2); PG8_BAR;
        PG8_STAGE(PG8_SB(1, 0), cB + kstep, voffB); PG8_STAGE(PG8_SA(1, 0), cA + kstep, voffA); PG8_STAGE(PG8_SB(1, 1), cB + hstepB + kstep, voffB);
        PG8_WAIT_V(6); PG8_BAR;
    } else {
        PG8_STAGE(PG8_SB(0, 0), cB, voffB); PG8_STAGE(PG8_SA(0, 0), cA, voffA); PG8_STAGE(PG8_SB(0, 1), cB + hstepB, voffB); PG8_STAGE(PG8_SA(0, 1), cA + hstepA, voffA);
        if (wr == 1) PG8_BAR;
        PG8_WAIT_V(4); PG8_BAR;
        PG8_STAGE(PG8_SB(1, 0), cB + kstep, voffB); PG8_STAGE(PG8_SA(1, 0), cA + kstep, voffA); PG8_STAGE(PG8_SB(1, 1), cB + hstepB + kstep, voffB);
        PG8_WAIT_V(6); PG8_BAR;
    }
    for (;;) {
        const bool has_next = S.next(ui + 1, nxt);
        const char* nA = has_next ? (const char*)g.A + (size_t)nxt.pm * tstepA : cA; const char* nB = has_next ? (const char*)g.Bt + (size_t)nxt.pn * tstepB : cB;
#pragma unroll 1
        for (int t = 0; t < nt; t += 2) {
            const bool last = (t == nt - 2);
            const char* a1 = cA + (size_t)(t + 1) * kstep;
            const char* a2 = last ? nA : cA + (size_t)(t + 2) * kstep; const char* b2 = last ? nB : cB + (size_t)(t + 2) * kstep;
            const char* a3 = a2 + kstep; const char* b3 = b2 + kstep;
            if (last && has_next) S.a_ready(nxt);
            if constexpr (SP2) {
            PG8_LDB(B0, 0, 0); PG8_LDB(B1, 0, 1); PG8_SCHED; PG8_LDA(At, 0, 0); PG8_STAGE(PG8_SA(1, 1), a1 + hstepA, voffA);
            PG8_WAIT_V(8); PG8_WAIT_L(0); PG8_BAR; PG8_MMA(0, 0, At, B0); PG8_MMA(0, 1, At, B1); PG8_BAR; PG8_SCHED;
            PG8_LDA(At, 0, 1); PG8_STAGE(PG8_SB(0, 0), b2, voffB); PG8_STAGE(PG8_SB(0, 1), b2 + hstepB, voffB); PG8_STAGE(PG8_SA(0, 0), a2, voffA);
            PG8_WAIT_V(8); PG8_WAIT_L(0); PG8_BAR; PG8_MMA(1, 0, At, B0); PG8_MMA(1, 1, At, B1); PG8_BAR; PG8_SCHED;
            PG8_LDB(B0, 1, 0); PG8_LDB(B1, 1, 1); PG8_SCHED; PG8_LDA(At, 1, 0); PG8_STAGE(PG8_SA(0, 1), a2 + hstepA, voffA);
            PG8_WAIT_V(8); PG8_WAIT_L(0); PG8_BAR; PG8_MMA(0, 0, At, B0); PG8_MMA(0, 1, At, B1); PG8_BAR; PG8_SCHED;
            PG8_LDA(At, 1, 1); PG8_STAGE(PG8_SB(1, 0), b3, voffB); PG8_STAGE(PG8_SB(1, 1), b3 + hstepB, voffB); PG8_STAGE(PG8_SA(1, 0), a3, voffA);
            PG8_WAIT_V(8); PG8_WAIT_L(0); PG8_BAR; PG8_MMA(1, 0, At, B0); PG8_MMA(1, 1, At, B1); PG8_BAR; PG8_SCHED;
            } else {
            PG8_LDB(B0, 0, 0); PG8_SCHED; PG8_LDA(At, 0, 0); PG8_STAGE(PG8_SA(1, 1), a1 + hstepA, voffA);
            PG8_WAIT_L(8); PG8_BAR; PG8_WAIT_L(0); PG8_MMA(0, 0, At, B0); PG8_BAR; PG8_SCHED;
            PG8_LDB(B1, 0, 1); PG8_STAGE(PG8_SB(0, 0), b2, voffB);
            PG8_BAR; PG8_WAIT_L(0); PG8_MMA(0, 1, At, B1); PG8_BAR;
            PG8_LDA(At, 0, 1); PG8_STAGE(PG8_SA(0, 0), a2, voffA);
            PG8_BAR; PG8_WAIT_L(0); PG8_MMA(1, 0, At, B0); PG8_BAR; PG8_SCHED;
            PG8_STAGE(PG8_SB(0, 1), b2 + hstepB, voffB);
            PG8_WAIT_V(6); PG8_BAR; PG8_MMA(1, 1, At, B1); PG8_BAR;
            PG8_LDB(B0, 1, 0); PG8_SCHED; PG8_LDA(At, 1, 0); PG8_STAGE(PG8_SA(0, 1), a2 + hstepA, voffA);
            PG8_WAIT_L(8); PG8_BAR; PG8_WAIT_L(0); PG8_MMA(0, 0, At, B0); PG8_BAR; PG8_SCHED;
            PG8_LDB(B1, 1, 1); PG8_STAGE(PG8_SB(1, 0), b3, voffB);
            PG8_BAR; PG8_WAIT_L(0); PG8_MMA(0, 1, At, B1); PG8_BAR;
            PG8_LDA(At, 1, 1); PG8_STAGE(PG8_SA(1, 0), a3, voffA);
            PG8_BAR; PG8_WAIT_L(0); PG8_MMA(1, 0, At, B0); PG8_BAR; PG8_SCHED;
            PG8_STAGE(PG8_SB(1, 1), b3 + hstepB, voffB);
            PG8_WAIT_V(6); PG8_BAR; PG8_MMA(1, 1, At, B1); PG8_BAR;
            }
        }
        if constexpr (ALIGN_EPI) { if (wr == 0) PG8_BAR; }
        if constexpr (!Epi::AFTER_DRAIN) { E(acc, cur, wr, wc, fr, fq); S.done(cur); }
        if (!has_next) break;
#pragma unroll
        for (int a = 0; a < 2; ++a)
#pragma unroll
            for (int b = 0; b < 2; ++b)
#pragma unroll
                for (int m = 0; m < 4; ++m)
#pragma unroll
                    for (int n = 0; n < 2; ++n) acc[a][b][m][n] = (f32x4){0.f, 0.f, 0.f, 0.f};
        cur = nxt; cA = nA; cB = nB; ++ui;
        if constexpr (ALIGN_EPI) { if (wr == 1) PG8_BAR; }
    }
    PG8_WAIT_V(0);
    if constexpr (!ALIGN_EPI) { if (wr == 0) PG8_BAR; }
    PG8_BAR;
    if constexpr (Epi::AFTER_DRAIN) { E.fused(acc, cur, wr, wc, fr, fq, lds, wid, lane); S.done(cur); }
#undef PG8_SA
#undef PG8_SB
#undef PG8_STAGE
#undef PG8_LDA
#undef PG8_LDB
#undef PG8_MMA
#undef PG8_WAIT_V
#undef PG8_WAIT_L
#undef PG8_BAR
#undef PG8_SCHED
}
}

#define LAS __attribute__((address_space(3)))
typedef unsigned short bf16;
typedef pg8::f32x4 f32x4; typedef pg8::u32x4 u32x4; typedef pg8::bf16x8 bf16x8;
typedef float f32x16 __attribute__((ext_vector_type(16)));
typedef float f32x2 __attribute__((ext_vector_type(2)));
typedef __bf16 bf16x2_t __attribute__((ext_vector_type(2)));
typedef unsigned u32x2 __attribute__((ext_vector_type(2)));
typedef short s16x4 __attribute__((ext_vector_type(4)));

constexpr int DM = 1024, NBATCH = 8, SEQ = 4096, NMETA = 16, LTOK = 4112;
constexpr int MAINR = NBATCH * SEQ;
constexpr int RP = 33024;
constexpr int CROWS = NBATCH * LTOK;
constexpr int INC = 4096, DFF = 2816, UPC = 5632;
constexpr int NG = 32, NCHK = 257, NCP = 2304, UMK = 384;
constexpr float EPS = 1e-6f, LOG2E = 1.4426950408889634f;
constexpr int NWAVES = 8;

constexpr size_t MiB = 1u << 20;
constexpr size_t WS_BAR = 524288;
constexpr size_t WS_R1 = 0, WS_SS2 = 135168, WS_H1M = 274432, WS_LAM16 = 344064, WS_AM = 364544;
constexpr size_t WS_WIN = 1 * MiB, WS_WGLU = 9 * MiB, WS_WSO = 9 * MiB + 512 * 1024, WS_WAO = 10 * MiB + 512 * 1024, WS_WO = 11 * MiB + 512 * 1024,
                 WS_WUP = 13 * MiB + 512 * 1024, WS_WDN = 24 * MiB + 512 * 1024, WS_TE = 30 * MiB, WS_F = 36 * MiB, WS_CP = 40 * MiB, WS_BP = 43 * MiB, WS_AT = 46 * MiB;
constexpr size_t WS_XB = 50 * MiB;
constexpr size_t WS_UM = 115 * MiB, WS_H1B = WS_UM;
constexpr size_t WS_QB = 169 * MiB, WS_KB = WS_QB + 33816576, WS_VB = WS_KB + 33816576, WS_YSS = WS_QB, WS_PATT = WS_KB;
constexpr size_t WS_GSA = 266 * MiB, WS_EB = 395 * MiB, WS_YATT = 431 * MiB, WS_YG = WS_YATT + 33816576, WS_MIX = WS_YATT;
constexpr size_t WS_ACT = 202 * MiB;
constexpr size_t WS_SS2P = 496 * MiB;
constexpr size_t WS_END = 499 * MiB;
static_assert(WS_VB + 33816576 <= WS_GSA && WS_YG + 33816576 <= WS_END && WS_ACT + (size_t)MAINR * DFF * 2 <= WS_EB && WS_H1B + (size_t)RP * DM * 2 <= WS_ACT, "ws map");

constexpr int LDS_BYTES = 147456;
constexpr int LDS_X = 131072;

__device__ __forceinline__ unsigned cvtpk(float lo, float hi) { f32x2 v = {lo, hi}; bf16x2_t b = __builtin_convertvector(v, bf16x2_t); return __builtin_bit_cast(unsigned, b); }
__device__ __forceinline__ bf16 f2bf(float f) { return (bf16)(cvtpk(f, 0.f) & 0xffffu); }
__device__ __forceinline__ float bflo(unsigned u) { return __builtin_bit_cast(float, u << 16); }
__device__ __forceinline__ float bfhi(unsigned u) { return __builtin_bit_cast(float, u & 0xffff0000u); }
__device__ __forceinline__ void st8(bf16* p, f32x4 a, f32x4 b) { u32x4 w; w.x = cvtpk(a[0], a[1]); w.y = cvtpk(a[2], a[3]); w.z = cvtpk(b[0], b[1]); w.w = cvtpk(b[2], b[3]); *(u32x4*)p = w; }
__device__ __forceinline__ void ld8(const bf16* p, f32x4& a, f32x4& b) { const u32x4 w = *(const u32x4*)p; a = (f32x4){bflo(w.x), bfhi(w.x), bflo(w.y), bfhi(w.y)}; b = (f32x4){bflo(w.z), bfhi(w.z), bflo(w.w), bfhi(w.w)}; }
__device__ __forceinline__ void un8(const u32x4 w, f32x4& a, f32x4& b) { a = (f32x4){bflo(w.x), bfhi(w.x), bflo(w.y), bfhi(w.y)}; b = (f32x4){bflo(w.z), bfhi(w.z), bflo(w.w), bfhi(w.w)}; }
__device__ __forceinline__ unsigned q8x4(f32x4 s) { const f32x4 t = s * 255.f + 0.5f; return (unsigned)t[0] | ((unsigned)t[1] << 8) | ((unsigned)t[2] << 16) | ((unsigned)t[3] << 24); }
__device__ __forceinline__ f32x4 dq8x4(unsigned w) { return (f32x4){(float)(w & 0xffu), (float)((w >> 8) & 0xffu), (float)((w >> 16) & 0xffu), (float)(w >> 24)} * (1.f / 255.f); }
__device__ __forceinline__ float fsig(float x) { return __builtin_amdgcn_rcpf(1.f + __builtin_amdgcn_exp2f(-LOG2E * x)); }
__device__ __forceinline__ float fgelu(float x) { const float t = x * (-2.302208198f - 0.1029432397f * x * x); return x * __builtin_amdgcn_rcpf(1.f + __builtin_amdgcn_exp2f(t)); }
__device__ __forceinline__ f32x4 sig4(f32x4 v) { return (f32x4){fsig(v[0]), fsig(v[1]), fsig(v[2]), fsig(v[3])}; }
__device__ __forceinline__ f32x4 gelu4(f32x4 v) { return (f32x4){fgelu(v[0]), fgelu(v[1]), fgelu(v[2]), fgelu(v[3])}; }
__device__ __forceinline__ float wave_sum(float v) {
#pragma unroll
    for (int o = 1; o < 64; o <<= 1) v += __shfl_xor(v, o);
    return v;
}
__device__ __forceinline__ float sq4(f32x4 v) { return (v[0] * v[0] + v[1] * v[1]) + (v[2] * v[2] + v[3] * v[3]); }

struct Params { const float* in[29]; float* out; unsigned char* ws; int ph_lo, ph_hi; };
typedef const __attribute__((address_space(4))) unsigned char* kaptr_t;
__device__ __forceinline__ kaptr_t KA() { kaptr_t ka = (kaptr_t)__builtin_amdgcn_kernarg_segment_ptr(); asm volatile("" : "+s"(ka)); return ka; }
#define KARG64(off) (*(const __attribute__((address_space(4))) unsigned long long*)(KA() + (off)))
#define GAS __attribute__((address_space(1)))
#define INP(k) ((const float*)(GAS const float*)KARG64(8 * (k)))
#define OUTP() ((float*)(GAS float*)KARG64(232))
#define WSP() ((unsigned char*)(GAS unsigned char*)KARG64(240))
static_assert(sizeof(Params) == 256, "Params layout");

template <class F> struct EpiG {
    static constexpr bool PERM = true, AFTER_DRAIN = false; F f;
    __device__ __forceinline__ void operator()(const f32x4 (&acc)[2][2][4][2], const pg8::Unit& u, int wr, int wc, int fr, int fq) const {
        const int cl = u.pn * 256 + 64 * wc + 8 * fq, row0 = u.pm * 256 + wr * 64 + fr;
        typename F::Pre pre = f.load(row0, cl);
#pragma unroll
        for (int i = 0; i < 8; ++i) {
            const int ai = i >> 2, m = i & 3, row = row0 + ai * 128 + m * 16;
            typename F::Pre nxt = pre;
            if (i + 1 < 8) nxt = f.load(row0 + ((i + 1) >> 2) * 128 + ((i + 1) & 3) * 16, cl);
            f.apply(row, cl, pre, acc[ai][0][m][0], acc[ai][0][m][1], acc[ai][1][m][0], acc[ai][1][m][1]);
            pre = nxt;
        }
    }
};
template <class F> __device__ __forceinline__ void skinny_task(const bf16* A16, int lda, const bf16* Bt, int ldb, int K, int pn, int wc, int lane, int wave, LAS float* red, int rowbase, int clbase, const F& f) {
    const int fr = lane & 15, fq = lane >> 4;
    typename F::Pre pre = f.load(rowbase + fr, clbase + 8 * fq);
    f32x4 c00 = {0.f, 0.f, 0.f, 0.f}, c01 = c00, c10 = c00, c11 = c00;
    const bf16* tb = Bt + (size_t)(pn * 256 + 32 * wc) * ldb + fq * 8;
    const bf16* b00 = tb + (size_t)pg8::perm32(fr) * ldb; const bf16* b01 = tb + (size_t)pg8::perm32(16 + fr) * ldb;
    const bf16* b10 = b00 + (size_t)128 * ldb; const bf16* b11 = b01 + (size_t)128 * ldb;
    const bf16* ap = A16 + (size_t)fr * lda + fq * 8;
#pragma unroll 4
    for (int k0 = 32 * wave; k0 < K; k0 += 256) {
        const bf16x8 a = *(const bf16x8*)(ap + k0);
        const bf16x8 v00 = *(const bf16x8*)(b00 + k0), v01 = *(const bf16x8*)(b01 + k0), v10 = *(const bf16x8*)(b10 + k0), v11 = *(const bf16x8*)(b11 + k0);
        c00 = __builtin_amdgcn_mfma_f32_16x16x32_bf16(v00, a, c00, 0, 0, 0); c01 = __builtin_amdgcn_mfma_f32_16x16x32_bf16(v01, a, c01, 0, 0, 0);
        c10 = __builtin_amdgcn_mfma_f32_16x16x32_bf16(v10, a, c10, 0, 0, 0); c11 = __builtin_amdgcn_mfma_f32_16x16x32_bf16(v11, a, c11, 0, 0, 0);
    }
    LAS f32x4* R = (LAS f32x4*)red + (wave * 4) * 64 + lane;
    R[0] = c00; R[64] = c01; R[128] = c10; R[192] = c11;
    __syncthreads();
    if (wave == 0) {
        LAS const f32x4* S = (LAS const f32x4*)red + lane;
#pragma unroll
        for (int w = 1; w < 8; ++w) { c00 += S[(w * 4) * 64]; c01 += S[(w * 4 + 1) * 64]; c10 += S[(w * 4 + 2) * 64]; c11 += S[(w * 4 + 3) * 64]; }
        f.apply(rowbase + fr, clbase + 8 * fq, pre, c00, c01, c10, c11);
    }
    __syncthreads();
}
template <class F> __device__ __forceinline__ void skinny16(const bf16* A16, int lda, const bf16* Bt, int ldb, int N, int K, int bx, int G, int lane, int wave, LAS float* red, const F& f, int boff = 0) {
    asm volatile("" : "+v"(lane));
    for (int t = (bx - boff + G) % G; t < N / 64; t += G) skinny_task(A16, lda, Bt, ldb, K, t >> 2, t & 3, lane, wave, red, MAINR, t * 64, f);
}
template <class F> __device__ __forceinline__ void skinny_ssm(const bf16* UMp, const bf16* Bt, int ldb, int K, int bx, int G, int lane, int wave, LAS float* red, const F& f) {
    asm volatile("" : "+v"(lane));
    for (int t = bx; t < NG * 4; t += G) { const int g = t >> 2, wc = t & 3;
        skinny_task(UMp + (size_t)(g * NCP + 2048) * UMK, UMK, Bt + (size_t)g * 256 * ldb, ldb, K, 0, wc, lane, wave, red, g * NCP + 2048, g * 256 + 64 * wc, f); }
}

struct FIn {
    const float* r1; bf16* UM; bf16* QB; bf16* KB; bf16* VB; bf16* GSA; const float* qg; const float* kg;
    struct Pre { float r; };
    __device__ __forceinline__ Pre load(int row, int) const { return Pre{r1[row]}; }
    __device__ __forceinline__ void apply(int row, int cl, const Pre& P_, f32x4 a0, f32x4 a1, f32x4 b0, f32x4 b1) const {
        const float r = P_.r; a0 *= r; a1 *= r; b0 *= r; b1 *= r;
        const int g64 = cl & ~63;
        const bool meta = row >= MAINR;
        const int bb = row >> 12, tt = meta ? row - MAINR : 16 + (row & 4095);
        if (g64 < 512) {
            const int nb0 = meta ? 0 : bb, nb1 = meta ? NBATCH : bb + 1;
            for (int b = nb0; b < nb1; ++b) {
                const size_t base = (size_t)(b * NCHK + (tt >> 4)) * UMK + (tt & 15) * 16;
                st8(UM + (size_t)(cl >> 4) * NCP * UMK + base + (cl & 15), a0, a1);
                st8(UM + (size_t)((cl + 32) >> 4) * NCP * UMK + base + (cl & 15), b0, b1);
            }
        } else if (g64 < 2048) {
            const int sel = (g64 - 512) >> 9;
            bf16* dst = QB + (size_t)sel * 16908288; const int cc = cl - 512 - sel * 512;
            if (sel < 2) {
                float ss = (sq4(a0) + sq4(a1)) + (sq4(b0) + sq4(b1));
                ss += __shfl_xor(ss, 16); ss += __shfl_xor(ss, 32);
                const float rr = __builtin_amdgcn_rsqf(ss * (1.f / 64.f) + EPS) * (sel == 0 ? 0.125f * LOG2E : 1.f);
                const float* gp = qg + sel * (kg - qg) + (cl & 63);
                const f32x4 g0 = *(const f32x4*)gp, g1 = *(const f32x4*)(gp + 4), g2 = *(const f32x4*)(gp + 32), g3 = *(const f32x4*)(gp + 36);
                a0 = a0 * rr * g0; a1 = a1 * rr * g1; b0 = b0 * rr * g2; b1 = b1 * rr * g3;
            }
            const int nb0 = meta ? 0 : bb, nb1 = meta ? NBATCH : bb + 1;
            for (int b = nb0; b < nb1; ++b) { bf16* p = dst + (size_t)(b * LTOK + tt) * 512 + cc; st8(p, a0, a1); st8(p + 32, b0, b1); }
        } else {
            unsigned char* p = (unsigned char*)GSA + (size_t)row * 2048 + (cl - 2048);
            u32x2 w0, w1; w0.x = q8x4(sig4(a0)); w0.y = q8x4(sig4(a1)); w1.x = q8x4(sig4(b0)); w1.y = q8x4(sig4(b1));
            __builtin_nontemporal_store(w0, (u32x2*)p); __builtin_nontemporal_store(w1, (u32x2*)(p + 32));
        }
    }
};
struct FE {
    float* EB;
    struct Pre {};
    __device__ __forceinline__ Pre load(int, int) const { return Pre{}; }
    __device__ __forceinline__ void apply(int row, int cl, const Pre&, f32x4 a0, f32x4 a1, f32x4 b0, f32x4 b1) const {
        const int s = cl & 255;
        if (s < 128) { float* p = EB + (size_t)row * 128 + s; *(f32x4*)p = a0; *(f32x4*)(p + 4) = a1; *(f32x4*)(p + 32) = b0; *(f32x4*)(p + 36) = b1; }
    }
};
struct FY {
    bf16* YG;
    struct Pre {};
    __device__ __forceinline__ Pre load(int, int) const { return Pre{}; }
    __device__ __forceinline__ void apply(int row, int cl, const Pre&, f32x4 a0, f32x4 a1, f32x4 b0, f32x4 b1) const {
        const int g = row / NCP, n = row - g * NCP;
        if (n >= NBATCH * NCHK) return;
        const int b = n / NCHK, ch = n - b * NCHK, lc = cl & 255, c = lc & 15;
        const int tok0 = ch * 16 + (lc >> 4), tok1 = tok0 + 2;
        int o0, o1;
        if (ch == 0) { if (b != 0) return; o0 = MAINR + tok0; o1 = MAINR + tok1; } else { o0 = b * 4096 + tok0 - 16; o1 = o0 + 2; }
        st8(YG + (size_t)o0 * 512 + g * 16 + c, gelu4(a0), gelu4(a1));
        st8(YG + (size_t)o1 * 512 + g * 16 + c, gelu4(b0), gelu4(b1));
    }
};
struct FGlu {
    const bf16* YG; bf16* YSS; const float* bias;
    struct Pre { u32x4 y0, y1; };
    __device__ __forceinline__ Pre load(int row, int cl) const { const bf16* yp = YG + (size_t)row * 512 + cl; return Pre{*(const u32x4*)yp, *(const u32x4*)(yp + 32)}; }
    __device__ __forceinline__ void apply(int row, int cl, const Pre& P_, f32x4 a0, f32x4 a1, f32x4 b0, f32x4 b1) const {
        const float* bp = bias + cl;
        f32x4 y0, y1, y2, y3; un8(P_.y0, y0, y1); un8(P_.y1, y2, y3);
        a0 = y0 * sig4(a0 + *(const f32x4*)bp); a1 = y1 * sig4(a1 + *(const f32x4*)(bp + 4)); b0 = y2 * sig4(b0 + *(const f32x4*)(bp + 32)); b1 = y3 * sig4(b1 + *(const f32x4*)(bp + 36));
        bf16* p = YSS + (size_t)row * 512 + cl; st8(p, a0, a1); st8(p + 32, b0, b1);
    }
};
struct FPatt {
    const bf16* GSA; bf16* PATT;
    struct Pre { u32x2 g0, g1; };
    __device__ __forceinline__ Pre load(int row, int cl) const { const unsigned char* gp = (const unsigned char*)GSA + (size_t)row * 2048 + 1024 + cl; return Pre{__builtin_nontemporal_load((const u32x2*)gp), __builtin_nontemporal_load((const u32x2*)(gp + 32))}; }
    __device__ __forceinline__ void apply(int row, int cl, const Pre& P_, f32x4 a0, f32x4 a1, f32x4 b0, f32x4 b1) const {
        const f32x4 g0 = dq8x4(P_.g0.x), g1 = dq8x4(P_.g0.y), g2 = dq8x4(P_.g1.x), g3 = dq8x4(P_.g1.y);
        bf16* p = PATT + (size_t)row * 1024 + cl; st8(p, a0 * g0, a1 * g1); st8(p + 32, b0 * g2, b1 * g3);
    }
};
struct FMix {
    const bf16* GSA; const bf16* PATT; bf16* MIX;
    struct Pre { u32x2 g0, g1; u32x4 q0, q1; };
    __device__ __forceinline__ Pre load(int row, int cl) const { const unsigned char* gp = (const unsigned char*)GSA + (size_t)row * 2048 + cl; const bf16* pp = PATT + (size_t)row * 1024 + cl;
        return Pre{__builtin_nontemporal_load((const u32x2*)gp), __builtin_nontemporal_load((const u32x2*)(gp + 32)), __builtin_nontemporal_load((const u32x4*)pp), __builtin_nontemporal_load((const u32x4*)(pp + 32))}; }
    __device__ __forceinline__ void apply(int row, int cl, const Pre& P_, f32x4 a0, f32x4 a1, f32x4 b0, f32x4 b1) const {
        const f32x4 g0 = dq8x4(P_.g0.x), g1 = dq8x4(P_.g0.y), g2 = dq8x4(P_.g1.x), g3 = dq8x4(P_.g1.y);
        f32x4 p0, p1, p2, p3; un8(P_.q0, p0, p1); un8(P_.q1, p2, p3);
        bf16* p = MIX + (size_t)row * 1024 + cl; st8(p, p0 + a0 * g0, p1 + a1 * g1); st8(p + 32, p2 + b0 * g2, p3 + b1 * g3);
    }
};
struct FWo {
    const bf16* XB; bf16* H1B; float* ss2;
    struct Pre { u32x4 h0, h1; };
    __device__ __forceinline__ Pre load(int row, int cl) const { const bf16* hp = XB + (size_t)row * 1024 + cl; return Pre{__builtin_nontemporal_load((const u32x4*)hp), __builtin_nontemporal_load((const u32x4*)(hp + 32))}; }
    __device__ __forceinline__ void apply(int row, int cl, const Pre& P_, f32x4 a0, f32x4 a1, f32x4 b0, f32x4 b1) const {
        f32x4 h0, h1, h2, h3; un8(P_.h0, h0, h1); un8(P_.h1, h2, h3);
        a0 += h0; a1 += h1; b0 += h2; b1 += h3;
        bf16* p = H1B + (size_t)row * 1024 + cl; st8(p, a0, a1); st8(p + 32, b0, b1);
        float ss = (sq4(a0) + sq4(a1)) + (sq4(b0) + sq4(b1));
        ss += __shfl_xor(ss, 16); ss += __shfl_xor(ss, 32);
        if ((threadIdx.x & 63) < 16) atomicAdd(ss2 + row, ss);
    }
};
struct FDown {
    const bf16* H1B; float* out;
    struct Pre { u32x4 h0, h1; };
    __device__ __forceinline__ Pre load(int row, int cl) const { const bf16* hp = H1B + (size_t)row * 1024 + cl; return Pre{__builtin_nontemporal_load((const u32x4*)hp), __builtin_nontemporal_load((const u32x4*)(hp + 32))}; }
    __device__ __forceinline__ void apply(int row, int cl, const Pre& P_, f32x4 a0, f32x4 a1, f32x4 b0, f32x4 b1) const {
        f32x4 h0, h1, h2, h3; un8(P_.h0, h0, h1); un8(P_.h1, h2, h3);
        float* op = out + (size_t)row * 1024 + cl;
        __builtin_nontemporal_store(a0 + h0, (f32x4*)op); __builtin_nontemporal_store(a1 + h1, (f32x4*)(op + 4)); __builtin_nontemporal_store(b0 + h2, (f32x4*)(op + 32)); __builtin_nontemporal_store(b1 + h3, (f32x4*)(op + 36));
    }
};
__device__ __forceinline__ float row_rs(const float* ss2p, int row) {
    const f32x4* q = (const f32x4*)(ss2p + (size_t)row * 16); const f32x4 a = q[0], b = q[1], c = q[2], d = q[3];
    const f32x4 s = (a + b) + (c + d); return __builtin_amdgcn_rsqf(((s[0] + s[1]) + (s[2] + s[3])) * (1.f / 1024.f) + EPS);
}
struct FUpMeta {
    const float* ss2; float* AM;
    struct Pre {};
    __device__ __forceinline__ Pre load(int, int) const { return Pre{}; }
    __device__ __forceinline__ void apply(int row, int cl, const Pre&, f32x4 a0, f32x4 a1, f32x4 b0, f32x4 b1) const {
        const int t = row - MAINR; if (t < 14) return;
        const float r = __builtin_amdgcn_rsqf(ss2[row] * (1.f / 1024.f) + EPS);
        const int hid = 128 * (cl >> 8) + 32 * ((cl >> 6) & 3) + (cl & 31);
        float* p = AM + (size_t)(t - 14) * DFF + hid; *(f32x4*)p = a0 * r; *(f32x4*)(p + 4) = a1 * r;
    }
};

__device__ __forceinline__ float rot1(float v) { float r = __builtin_bit_cast(float, __builtin_amdgcn_update_dpp(0, __builtin_bit_cast(int, v), 0x121, 0xf, 0xf, false)); asm volatile("" : "+v"(r)); return r; }
__device__ __forceinline__ float rot2(float v) { float r = __builtin_bit_cast(float, __builtin_amdgcn_update_dpp(0, __builtin_bit_cast(int, v), 0x122, 0xf, 0xf, false)); asm volatile("" : "+v"(r)); return r; }
struct EpiUp {
    static constexpr bool PERM = true, AFTER_DRAIN = false;
    const float* ss2; const float* cw; const float* cb; bf16* ACT; float* CP; float* BP; float* AT; LAS float* tails;
    __device__ __forceinline__ void operator()(const f32x4 (&acc)[2][2][4][2], const pg8::Unit& u, int wr, int wc, int fr, int fq) const {
        const int hid = 128 * u.pn + 32 * wc + 8 * fq;
        f32x4 w0[2], w1[2], w2[2], bv[2];
#pragma unroll
        for (int n = 0; n < 2; ++n) { w0[n] = *(const f32x4*)(cw + hid + 4 * n); w1[n] = *(const f32x4*)(cw + DFF + hid + 4 * n); w2[n] = *(const f32x4*)(cw + 2 * DFF + hid + 4 * n); bv[n] = *(const f32x4*)(cb + hid + 4 * n); }
        LAS f32x4* T = (LAS f32x4*)tails;
        float rs[2][4];
#pragma unroll
        for (int ai = 0; ai < 2; ++ai)
#pragma unroll
            for (int m = 0; m < 4; ++m) rs[ai][m] = __builtin_amdgcn_rsqf(ss2[u.pm * 256 + ai * 128 + wr * 64 + m * 16 + fr] * (1.f / 1024.f) + EPS);
        if (fr >= 14) {
#pragma unroll
            for (int ai = 0; ai < 2; ++ai)
#pragma unroll
                for (int n = 0; n < 2; ++n) T[((((ai * 2 + wr) * 4 + wc) * 2 + n) * 4 + fq) * 2 + (fr - 14)] = acc[ai][0][3][n] * rs[ai][3];
        }
        asm volatile("s_waitcnt lgkmcnt(0)" ::: "memory"); __builtin_amdgcn_s_barrier(); asm volatile("" ::: "memory");
#pragma unroll
        for (int ai = 0; ai < 2; ++ai) {
            const int band = ai * 2 + wr;
            f32x4 pm1[2];
#pragma unroll
            for (int n = 0; n < 2; ++n) { pm1[n] = (f32x4){0.f, 0.f, 0.f, 0.f}; if (band > 0 && fr >= 14) pm1[n] = T[(((( band - 1) * 4 + wc) * 2 + n) * 4 + fq) * 2 + (fr - 14)]; }
#pragma unroll
            for (int m = 0; m < 4; ++m) {
                const int row = u.pm * 256 + ai * 128 + wr * 64 + m * 16 + fr;
                f32x4 o[2], bo[2];
#pragma unroll
                for (int n = 0; n < 2; ++n) {
                    const f32x4 xa = acc[ai][0][m][n] * rs[ai][m];
                    const f32x4 xp = (m == 0) ? pm1[n] : acc[ai][0][m - 1][n] * rs[ai][m - 1];
                    bo[n] = acc[ai][1][m][n] * rs[ai][m];
#pragma unroll
                    for (int j = 0; j < 4; ++j) {
                        const float y1 = fr == 15 ? xp[j] : xa[j], y2 = fr >= 14 ? xp[j] : xa[j];
                        const float p1 = rot1(y1), p2 = rot2(y2);
                        o[n][j] = bv[n][j] + w2[n][j] * xa[j] + w1[n][j] * p1 + w0[n][j] * p2;
                    }
                }
                if (band == 0 && m == 0 && fr < 2) {
                    float* cp = CP + (size_t)(u.pm * 2 + fr) * DFF + hid; float* bp = BP + (size_t)(u.pm * 2 + fr) * DFF + hid;
                    *(f32x4*)cp = o[0]; *(f32x4*)(cp + 4) = o[1]; *(f32x4*)bp = bo[0]; *(f32x4*)(bp + 4) = bo[1];
                } else {
                    st8(ACT + (size_t)row * DFF + hid, gelu4(o[0]) * bo[0], gelu4(o[1]) * bo[1]);
                }
                if (band == 3 && m == 3 && fr >= 14) {
                    float* ap = AT + (size_t)(u.pm * 2 + fr - 14) * DFF + hid;
                    *(f32x4*)ap = acc[ai][0][m][0] * rs[ai][m]; *(f32x4*)(ap + 4) = acc[ai][0][m][1] * rs[ai][m];
                }
            }
        }
    }
};

struct SsmOrder {
    int G, c;
    __device__ __forceinline__ bool next(int i, pg8::Unit& u) const { const int L = i * G + c; if (L >= NG * 8) return false; u.pm = (L >> 3) * 9 + (L & 7); u.pn = L >> 3; return true; }
    __device__ __forceinline__ void a_ready(const pg8::Unit&) const {}
    __device__ __forceinline__ void done(const pg8::Unit&) const {}
};
#define XB_TMO      128
#define XB_XCNT(j)  (256  + 64 * (j))
#define XB_XSUB(j)  (1280 + 64 * (j))
#define XB_XGEN(j)  (2304 + 64 * (j))
#define XB_TOP      3328
#define XB_TOPGEN   3392
#define XCD_BAR_WORDS 3456
#define XB_SPIN_CAP (1u << 18)

__device__ __forceinline__ unsigned xb_ld(unsigned* p)              { return __hip_atomic_load(p, __ATOMIC_RELAXED, __HIP_MEMORY_SCOPE_AGENT); }
__device__ __forceinline__ unsigned xb_add(unsigned* p, unsigned v) { return __hip_atomic_fetch_add(p, v, __ATOMIC_RELAXED, __HIP_MEMORY_SCOPE_AGENT); }
__device__ __forceinline__ unsigned xb_xcc_id() { return (unsigned)__builtin_amdgcn_s_getreg((3 << 11) | 20) & 0xFu; }
#define XB_SPIN(cond, bar) do { unsigned _sp = 0; while (cond) { __builtin_amdgcn_s_sleep(1); \
    if ((++_sp & 255u) == 0u) { if (xb_ld(&(bar)[XB_TMO])) break; if (_sp > XB_SPIN_CAP) { atomicAdd(&(bar)[XB_TMO], 1u); break; } } } } while (0)

struct XcdBarrier {
    unsigned* bar; unsigned x;
    volatile LAS unsigned* st;
};

__device__ __forceinline__ XcdBarrier xcd_barrier_post(unsigned* bar, volatile LAS unsigned* st) {
    XcdBarrier b; b.bar = bar; b.x = xb_xcc_id(); b.st = st;
    if (threadIdx.x == 0) (void)xb_add(&bar[XB_XCNT(b.x)], 1u);
    return b;
}
__device__ __forceinline__ void xcd_barrier_complete(unsigned* bar, unsigned x, unsigned& nloc, unsigned& nx) {
    const unsigned G = gridDim.x * gridDim.y * gridDim.z;
    unsigned sum, cnt, mine, sp = 0u;
    for (;;) {
        sum = 0u; cnt = 0u; mine = 0u;
#pragma unroll
        for (unsigned j = 0; j < 16; ++j) { const unsigned c = xb_ld(&bar[XB_XCNT(j)]); sum += c; cnt += (c > 0u) ? 1u : 0u; mine = (j == x) ? c : mine; }
        if (sum == G) break;
        __builtin_amdgcn_s_sleep(1);
        if ((++sp & 255u) == 0u) { if (xb_ld(&bar[XB_TMO])) break; if (sp > XB_SPIN_CAP) { atomicAdd(&bar[XB_TMO], 1u); break; } }
    }
    nloc = mine > 0u ? mine : 1u; nx = cnt > 0u ? cnt : 1u;
}

__device__ __forceinline__ void xcd_barrier(const XcdBarrier& b) {
    asm volatile("s_waitcnt vmcnt(0)" ::: "memory");
    __syncthreads();
    if (threadIdx.x == 0) {
        unsigned* bar = b.bar;
        __builtin_amdgcn_s_waitcnt(0);
        unsigned nloc = b.st[0], nx = b.st[1];
        if (nloc == 0u) { xcd_barrier_complete(bar, b.x, nloc, nx); b.st[0] = nloc; b.st[1] = nx; }
        const unsigned old = xb_add(&bar[XB_XSUB(b.x)], 1u);
        const unsigned gen = old / nloc;
        if (old + 1u == (gen + 1u) * nloc) {
            __builtin_amdgcn_fence(__ATOMIC_RELEASE, "agent");
            asm volatile("s_waitcnt vmcnt(0)" ::: "memory");
            const unsigned og = xb_add(&bar[XB_TOP], 1u);
            const unsigned tg = og / nx;
            if (og + 1u == (tg + 1u) * nx) xb_add(&bar[XB_TOPGEN], 1u);
            else XB_SPIN(xb_ld(&bar[XB_TOPGEN]) == tg, bar);
            __builtin_amdgcn_fence(__ATOMIC_ACQUIRE, "agent");
            xb_add(&bar[XB_XGEN(b.x)], 1u);
            asm volatile("s_waitcnt vmcnt(0)" ::: "memory");
        } else {
            XB_SPIN(xb_ld(&bar[XB_XGEN(b.x)]) == gen, bar);
            __builtin_amdgcn_fence(__ATOMIC_ACQUIRE, "agent");
            asm volatile("s_waitcnt vmcnt(0)" ::: "memory");
        }
    }
    __syncthreads();
}

constexpr int AK_STRIDE = 144, AK_BYTES = 64 * AK_STRIDE, AV_BYTES = 16384, A_KOFF = 0, A_VOFF = 4 * AK_BYTES, A_STASH = A_VOFF + 2 * AV_BYTES;
__device__ __forceinline__ int crow(int r, int hi) { return (r & 3) + 8 * (r >> 2) + 4 * hi; }
__device__ __forceinline__ s16x4 vtr(LAS const unsigned char* p) { typedef short v4i16_t __attribute__((ext_vector_type(4))); return __builtin_bit_cast(s16x4, __builtin_amdgcn_ds_read_tr16_b64_v4i16((LAS v4i16_t*)p)); }

__device__ __forceinline__ void attn_unit(const bf16* __restrict__ QB, const bf16* __restrict__ KB, const bf16* __restrict__ VB, bf16* __restrict__ YATT,
                                          const float* __restrict__ sg, float lam, int b, int h, int q0, int jstart, int D, int NT, LAS unsigned char* lds) {
    int tid_ = threadIdx.x; asm volatile("" : "+v"(tid_));
    const int tid = tid_, lane = tid & 63, r32 = lane & 31, hi = lane >> 5; const int wid = __builtin_amdgcn_readfirstlane(tid >> 6);
    const int jc = wid >> 2, w4 = wid & 3, hj = 2 * h + jc;
    const float slope = __builtin_amdgcn_exp2f(-2.f * (float)(h + 1)) * LOG2E;
    const bf16* Kg = KB + (size_t)(b * LTOK) * 512 + (2 * h) * 64;
    const bf16* Vg = VB + (size_t)(b * LTOK) * 512 + h * 128;
    const int tq = q0 + 32 * w4 + r32, tqc = tq < 0 ? 0 : tq;
    const int qref = q0 + 32 * w4;
    bf16x8 qr[4];
    { const bf16* Qrow = QB + (size_t)(b * LTOK + tqc) * 512 + hj * 64;
#pragma unroll
      for (int d0 = 0; d0 < 4; ++d0) qr[d0] = *(const bf16x8*)(Qrow + d0 * 16 + hi * 8); }
    const int jmax = (qref + 31) >> 6;
    const int jsw = qref - D > 0 ? (qref - D) >> 6 : 0;
    const int jd = qref >> 6;
    const float s_hi_f = bflo((unsigned)f2bf(slope)), s_lo_f = slope - s_hi_f;
    u32x4 bexw = {0u, 0u, 0u, 0u}, aex0w = {0u, 0u, 0u, 0u}, aex1w = {0u, 0u, 0u, 0u};
    if (hi == 0) { bexw.x = cvtpk(s_hi_f, s_lo_f); bexw.y = cvtpk(64.f * s_hi_f, 64.f * s_lo_f); aex0w.x = cvtpk((float)r32, (float)r32); aex1w.x = cvtpk((float)(32 + r32), (float)(32 + r32)); }
    const bf16x8 bex = __builtin_bit_cast(bf16x8, bexw);
    const bf16* ksrc[2]; int kdst[2];
#pragma unroll
    for (int i = 0; i < 2; ++i) { const int idx = tid + 512 * i, comp = idx >> 9, key = (idx >> 3) & 63, ch = idx & 7; ksrc[i] = Kg + (size_t)key * 512 + comp * 64 + ch * 8; kdst[i] = comp * AK_BYTES + key * AK_STRIDE + ch * 16; }
    const bf16* vsrc[2]; int vdst[2];
#pragma unroll
    for (int i = 0; i < 2; ++i) { const int idx = tid + 512 * i, key = idx >> 4, ch = idx & 15; vsrc[i] = Vg + (size_t)key * 512 + ch * 8; vdst[i] = ((key >> 3) * 4 + (ch >> 2)) * 512 + (key & 7) * 64 + (ch & 3) * 16; }
    LAS unsigned char* Kl = lds + A_KOFF; LAS unsigned char* Vl = lds + A_VOFF;
    const int kfo = jc * AK_BYTES + r32 * AK_STRIDE + hi * 16;
    const int vb = (4 * hi + ((lane & 15) >> 2)) * 64 + ((lane >> 4) & 1) * 32 + (lane & 3) * 8;
    f32x16 acc[4];
#pragma unroll
    for (int e = 0; e < 4; ++e) acc[e] = f32x16{};
    f32x16 negc = f32x16{};
    float lrun = 0.f;
    constexpr float THR = 60.f;
    u32x4 kreg[2], vreg[2];
    { const size_t go = (size_t)jstart * 64 * 512; kreg[0] = *(const u32x4*)(ksrc[0] + go); kreg[1] = *(const u32x4*)(ksrc[1] + go); vreg[0] = *(const u32x4*)(vsrc[0] + go); vreg[1] = *(const u32x4*)(vsrc[1] + go); }
    *(LAS u32x4*)(Kl + kdst[0]) = kreg[0]; *(LAS u32x4*)(Kl + kdst[1]) = kreg[1]; *(LAS u32x4*)(Vl + vdst[0]) = vreg[0]; *(LAS u32x4*)(Vl + vdst[1]) = vreg[1];
    __syncthreads();
    for (int j = jstart; j < NT; ++j) {
        const int cur = (j - jstart) & 1;
        if (j + 1 < NT) { const size_t go = (size_t)(j + 1) * 64 * 512; kreg[0] = *(const u32x4*)(ksrc[0] + go); kreg[1] = *(const u32x4*)(ksrc[1] + go); vreg[0] = *(const u32x4*)(vsrc[0] + go); vreg[1] = *(const u32x4*)(vsrc[1] + go); }
        if (j >= jsw && j <= jmax) {
            LAS const unsigned char* Kc = Kl + cur * 2 * AK_BYTES + kfo; LAS const unsigned char* Vc = Vl + cur * AV_BYTES + vb;
            { const float jr = (float)(j - jd); const unsigned jw = hi == 0 ? cvtpk(jr, jr) : 0u; aex0w.y = jw; aex1w.y = jw; }
            f32x16 s0 = __builtin_amdgcn_mfma_f32_32x32x16_bf16(__builtin_bit_cast(bf16x8, aex0w), bex, negc, 0, 0, 0);
            f32x16 s1 = __builtin_amdgcn_mfma_f32_32x32x16_bf16(__builtin_bit_cast(bf16x8, aex1w), bex, negc, 0, 0, 0);
#pragma unroll
            for (int d0 = 0; d0 < 4; ++d0) {
                const bf16x8 k0 = *(LAS const bf16x8*)(Kc + d0 * 32);
                const bf16x8 k1 = *(LAS const bf16x8*)(Kc + 32 * AK_STRIDE + d0 * 32);
                s0 = __builtin_amdgcn_mfma_f32_32x32x16_bf16(k0, qr[d0], s0, 0, 0, 0);
                s1 = __builtin_amdgcn_mfma_f32_32x32x16_bf16(k1, qr[d0], s1, 0, 0, 0);
            }
            if (64 * j + 63 > qref) {
                const int qrel = tqc - 64 * j - 4 * hi;
#pragma unroll
                for (int r = 0; r < 16; ++r) { const int kk = (r & 3) + 8 * (r >> 2); if (kk > qrel) s0[r] = -1e30f; if (kk + 32 > qrel) s1[r] = -1e30f; }
            }
            float mx = fmaxf(s0[0], s1[0]);
#pragma unroll
            for (int r = 1; r < 16; ++r) mx = fmaxf(mx, fmaxf(s0[r], s1[r]));
            { auto rr = __builtin_amdgcn_permlane32_swap(__float_as_uint(mx), __float_as_uint(mx), false, false); mx = fmaxf(__uint_as_float(rr[0]), __uint_as_float(rr[1])); }
            const bool need = (j == jsw) || (mx > THR);
            if (__any(need)) {
                const float delta = need ? mx : 0.f;
                const float alpha = (j == jsw) ? 1.f : __builtin_amdgcn_exp2f(-delta);
                lrun *= alpha;
#pragma unroll
                for (int r = 0; r < 16; ++r) { s0[r] -= delta; s1[r] -= delta; negc[r] -= delta; }
#pragma unroll
                for (int e = 0; e < 4; ++e)
#pragma unroll
                    for (int r = 0; r < 16; ++r) acc[e][r] *= alpha;
            }
            float ps = 0.f;
#pragma unroll
            for (int r = 0; r < 16; ++r) { s0[r] = __builtin_amdgcn_exp2f(s0[r]); s1[r] = __builtin_amdgcn_exp2f(s1[r]); ps += s0[r] + s1[r]; }
            lrun += ps;
            bf16x8 pf[4];
#pragma unroll
            for (int s = 0; s < 4; ++s) {
                u32x4 w;
                if (s < 2) { const int o = 8 * s; w.x = cvtpk(s0[o], s0[o + 1]); w.y = cvtpk(s0[o + 2], s0[o + 3]); w.z = cvtpk(s0[o + 4], s0[o + 5]); w.w = cvtpk(s0[o + 6], s0[o + 7]); }
                else { const int o = 8 * (s - 2); w.x = cvtpk(s1[o], s1[o + 1]); w.y = cvtpk(s1[o + 2], s1[o + 3]); w.z = cvtpk(s1[o + 4], s1[o + 5]); w.w = cvtpk(s1[o + 6], s1[o + 7]); }
                pf[s] = __builtin_bit_cast(bf16x8, w);
            }
#pragma unroll
            for (int s = 0; s < 4; ++s) {
#pragma unroll
                for (int e = 0; e < 4; ++e) {
                    const s16x4 lo = vtr(Vc + s * 4096 + e * 512), hv = vtr(Vc + s * 4096 + e * 512 + 2048);
                    const bf16x8 vf = (bf16x8){lo[0], lo[1], lo[2], lo[3], hv[0], hv[1], hv[2], hv[3]};
                    acc[e] = __builtin_amdgcn_mfma_f32_32x32x16_bf16(vf, pf[s], acc[e], 0, 0, 0);
                }
            }
        }
        if (j + 1 < NT) { const int nx = cur ^ 1; *(LAS u32x4*)(Kl + nx * 2 * AK_BYTES + kdst[0]) = kreg[0]; *(LAS u32x4*)(Kl + nx * 2 * AK_BYTES + kdst[1]) = kreg[1];
                          *(LAS u32x4*)(Vl + nx * AV_BYTES + vdst[0]) = vreg[0]; *(LAS u32x4*)(Vl + nx * AV_BYTES + vdst[1]) = vreg[1]; }
        __syncthreads();
    }
    { auto rr = __builtin_amdgcn_permlane32_swap(__float_as_uint(lrun), __float_as_uint(lrun), false, false); lrun = __uint_as_float(rr[0]) + __uint_as_float(rr[1]); }
    {
        const float inv = 1.f / lrun;
        LAS unsigned* stash = (LAS unsigned*)(lds + A_STASH) + w4 * 64 + lane;
        if (jc == 0) {
#pragma unroll
            for (int e = 0; e < 4; ++e)
#pragma unroll
                for (int i = 0; i < 8; ++i) stash[(e * 8 + i) * 256] = cvtpk(acc[e][2 * i] * inv, acc[e][2 * i + 1] * inv);
        }
        __syncthreads();
        if (jc == 1) {
            float ss = 0.f;
#pragma unroll
            for (int e = 0; e < 4; ++e)
#pragma unroll
                for (int i = 0; i < 8; ++i) { const unsigned w = stash[(e * 8 + i) * 256];
                    const float o0 = bflo(w) - lam * (acc[e][2 * i] * inv), o1 = bfhi(w) - lam * (acc[e][2 * i + 1] * inv);
                    acc[e][2 * i] = o0; acc[e][2 * i + 1] = o1; ss += o0 * o0 + o1 * o1; }
            { auto rr = __builtin_amdgcn_permlane32_swap(__float_as_uint(ss), __float_as_uint(ss), false, false); ss = __uint_as_float(rr[0]) + __uint_as_float(rr[1]); }
            const float rn = __builtin_amdgcn_rsqf(ss * (1.f / 128.f) + EPS) * 0.8f;
            if (tq >= 0 && jmax >= 0) {
                const int orow = tq < NMETA ? MAINR + tq : b * SEQ + tq - NMETA;
                bf16* op = YATT + (size_t)orow * 512 + h * 128 + 4 * hi;
#pragma unroll
                for (int e = 0; e < 4; ++e)
#pragma unroll
                    for (int i = 0; i < 4; ++i) { const f32x4 g = *(const f32x4*)(sg + 32 * e + 8 * i + 4 * hi);
                        u32x2 w; w.x = cvtpk(acc[e][4 * i] * rn * g[0], acc[e][4 * i + 1] * rn * g[1]); w.y = cvtpk(acc[e][4 * i + 2] * rn * g[2], acc[e][4 * i + 3] * rn * g[3]); *(u32x2*)(op + 32 * e + 8 * i) = w; }
            }
        }
        __syncthreads();
    }
}

__device__ __forceinline__ void ssm_scan(const float* __restrict__ EB, const float* __restrict__ LAM16, bf16* __restrict__ UM, int pair, int lane) {
    const int b = pair >> 5, g = pair & 31, p = lane;
    const float lr = LAM16[(g * 64 + p) * 2], li = LAM16[(g * 64 + p) * 2 + 1];
    float sr = 0.f, si = 0.f;
    const size_t row0 = (size_t)g * NCP + (size_t)b * NCHK;
    float er[8], ei[8], nr_[8], ni_[8];
#pragma unroll
    for (int k = 0; k < 8; ++k) { er[k] = EB[(row0 + k) * 128 + p]; ei[k] = EB[(row0 + k) * 128 + 64 + p]; }
    for (int c0 = 0; c0 < NCHK; c0 += 8) {
#pragma unroll
        for (int k = 0; k < 8; ++k) { const int c = c0 + 8 + k < NCHK ? c0 + 8 + k : NCHK - 1; nr_[k] = EB[(row0 + c) * 128 + p]; ni_[k] = EB[(row0 + c) * 128 + 64 + p]; }
#pragma unroll
        for (int k = 0; k < 8; ++k) if (c0 + k < NCHK) {
            bf16* up = UM + (row0 + c0 + k) * UMK + 256 + p; up[0] = f2bf(sr); up[64] = f2bf(si);
            const float nr = lr * sr - li * si + er[k], ni = lr * si + li * sr + ei[k]; sr = nr; si = ni;
        }
#pragma unroll
        for (int k = 0; k < 8; ++k) { er[k] = nr_[k]; ei[k] = ni_[k]; }
    }
}

__device__ __forceinline__ void tr_item(const float* __restrict__ W, int ldw, int K, bf16* __restrict__ WT, int nblk, int mapmode, const float* __restrict__ ksc, LAS float* scr, int item, int lane) {
    const int kb = item / nblk, nb = item - kb * nblk, k0 = 64 * kb, n0 = 32 * nb;
    const int L = (n0 & ~255) + 64 * ((n0 >> 5) & 3) + 32 * ((n0 >> 7) & 1);
    const int src0 = mapmode ? ((L >> 5) & 1) * DFF + 128 * (L >> 8) + 32 * ((L >> 6) & 3) : L;
    f32x4 v[8];
#pragma unroll
    for (int i = 0; i < 8; ++i) { const int kk = 8 * i + (lane >> 3); v[i] = __builtin_nontemporal_load((const f32x4*)(W + (size_t)(k0 + kk) * ldw + src0 + 4 * (lane & 7))); }
#pragma unroll
    for (int i = 0; i < 8; ++i) { const int kk = 8 * i + (lane >> 3); f32x4 w = v[i]; if (ksc) w *= ksc[k0 + kk];
        LAS float* d = scr + kk * 33 + 4 * (lane & 7); d[0] = w[0]; d[1] = w[1]; d[2] = w[2]; d[3] = w[3]; }
    asm volatile("s_waitcnt lgkmcnt(0)" ::: "memory");
    const int c = lane & 7;
#pragma unroll
    for (int j = 0; j < 4; ++j) { const int n = (lane >> 3) + 8 * j; const LAS float* s = scr + (8 * c) * 33 + n;
        u32x4 o; o.x = cvtpk(s[0 * 33], s[1 * 33]); o.y = cvtpk(s[2 * 33], s[3 * 33]); o.z = cvtpk(s[4 * 33], s[5 * 33]); o.w = cvtpk(s[6 * 33], s[7 * 33]);
        *(u32x4*)(WT + (size_t)(n0 + n) * K + k0 + 8 * c) = o; }
    asm volatile("s_waitcnt lgkmcnt(0)" ::: "memory");
}
template <int NR> __device__ __forceinline__ void rows_to_bf16(const float* const* src, bf16* const* dst, float* const* r1, int lane) {
    f32x4 v[NR][4];
#pragma unroll
    for (int r = 0; r < NR; ++r)
#pragma unroll
        for (int j = 0; j < 4; ++j) v[r][j] = __builtin_nontemporal_load((const f32x4*)src[r] + lane + 64 * j);
#pragma unroll
    for (int r = 0; r < NR; ++r) {
        float s = 0.f;
#pragma unroll
        for (int j = 0; j < 4; ++j) s += sq4(v[r][j]);
        s = wave_sum(s);
        if (lane == 0) *r1[r] = __builtin_amdgcn_rsqf(s * (1.f / 1024.f) + EPS);
        u32x2* o8 = (u32x2*)dst[r] + lane;
#pragma unroll
        for (int j = 0; j < 4; ++j) { u32x2 w; w.x = cvtpk(v[r][j][0], v[r][j][1]); w.y = cvtpk(v[r][j][2], v[r][j][3]); o8[64 * j] = w; }
    }
}
__device__ __forceinline__ void ssm_tables(int g, int part, LAS float* L, bf16* __restrict__ TE, bf16* __restrict__ FT, float* __restrict__ LAM16) {
    const int tid = threadIdx.x;
    LAS float* lkr = L;
    LAS float* lki = L + 17 * 64;
    LAS float* fr_ = L + 34 * 64;
    LAS float* fi_ = fr_ + 64;
    LAS float* Bbr = fi_ + 64;
    LAS float* Bbi = Bbr + 1024;
    LAS float* Cr = Bbi + 1024;
    LAS float* Ci = Cr + 1024;
    LAS float* Kt = Ci + 1024;
    const float dt = __expf(INP(6)[g]);
    if (tid < 64) {
        const int p = tid; const float are = INP(4)[g * 64 + p], aim = INP(5)[g * 64 + p];
        for (int k = 0; k <= 16; ++k) {
            const float mag = __expf(are * dt * (float)k);
            float rev = aim * dt * (float)k * 0.15915494309189535f; rev -= rintf(rev);
            lkr[k * 64 + p] = mag * __builtin_amdgcn_cosf(rev); lki[k * 64 + p] = mag * __builtin_amdgcn_sinf(rev);
        }
        const float lbr = lkr[64 + p], lbi = lki[64 + p], den = are * are + aim * aim, nre = lbr - 1.f;
        fr_[p] = (nre * are + lbi * aim) / den; fi_[p] = (lbi * are - nre * aim) / den;
        if (part == 0) { LAM16[(g * 64 + p) * 2] = lkr[16 * 64 + p]; LAM16[(g * 64 + p) * 2 + 1] = lki[16 * 64 + p]; }
    }
    __syncthreads();
    for (int i = tid; i < 1024; i += 512) {
        const int p = i >> 4; const float br = INP(7)[g * 1024 + i], bi = INP(8)[g * 1024 + i];
        Bbr[i] = fr_[p] * br - fi_[p] * bi; Bbi[i] = fr_[p] * bi + fi_[p] * br;
        Cr[i] = INP(9)[g * 1024 + i]; Ci[i] = INP(10)[g * 1024 + i];
    }
    __syncthreads();
    {
        const int k = tid >> 5, cl = (tid >> 4) & 1, c = 2 * part + cl, c2 = tid & 15; float s = 0.f;
        for (int p = 0; p < 64; ++p) {
            const float cr = Cr[c * 64 + p], ci = Ci[c * 64 + p], lr = lkr[k * 64 + p], li = lki[k * 64 + p];
            const float xr = cr * lr - ci * li, xi = cr * li + ci * lr;
            s += xr * Bbr[p * 16 + c2] - xi * Bbi[p * 16 + c2];
        }
        if (k == 0 && c == c2) s += INP(11)[g * 16 + c];
        Kt[tid] = s;
    }
    __syncthreads();
    for (int i = tid; i < 32 * 192; i += 512) {
        const int rr = i / 192, k = (i - rr * 192) * 2, t = rr >> 1, cl = rr & 1, c = 2 * part + cl;
        const int Lc = t * 16 + c, n = 128 * ((Lc >> 5) & 1) + 32 * (Lc >> 6) + (Lc & 31);
        float v[2];
#pragma unroll
        for (int q = 0; q < 2; ++q) { const int kk = k + q;
            if (kk < 256) { const int t2 = kk >> 4, c2 = kk & 15; v[q] = t >= t2 ? Kt[((t - t2) * 2 + cl) * 16 + c2] : 0.f; }
            else { const int p = (kk - 256) & 63; const float cr = Cr[c * 64 + p], ci = Ci[c * 64 + p], lr = lkr[(t + 1) * 64 + p], li = lki[(t + 1) * 64 + p];
                   v[q] = kk < 320 ? cr * lr - ci * li : -(cr * li + ci * lr); } }
        *(unsigned*)(TE + (size_t)(g * 256 + n) * UMK + k) = cvtpk(v[0], v[1]);
    }
    for (int i = tid; i < 32 * 128; i += 512) {
        const int rr = i >> 7, k = (i & 127) * 2, s = (rr < 16 ? 0 : 128) + 16 * part + (rr & 15);
        const int n = 128 * ((s >> 5) & 1) + 32 * (s >> 6) + (s & 31);
        float v[2] = {0.f, 0.f};
        if (s < 128) { const int p = s & 63;
#pragma unroll
            for (int q = 0; q < 2; ++q) { const int kk = k + q, jj = kk >> 4, c2 = kk & 15; const float lr = lkr[(15 - jj) * 64 + p], li = lki[(15 - jj) * 64 + p], br = Bbr[p * 16 + c2], bi = Bbi[p * 16 + c2];
                v[q] = s < 64 ? lr * br - li * bi : lr * bi + li * br; } }
        *(unsigned*)(FT + (size_t)(g * 256 + n) * 256 + k) = cvtpk(v[0], v[1]);
    }
    __syncthreads();
}

constexpr int NPHASE = 11;
#define R1 ((float*)(WSP() + WS_R1))
#define SS2 ((float*)(WSP() + WS_SS2))
#define H1M ((float*)(WSP() + WS_H1M))
#define LAM16 ((float*)(WSP() + WS_LAM16))
#define AM ((float*)(WSP() + WS_AM))
#define WIN ((bf16*)(WSP() + WS_WIN))
#define WGLU ((bf16*)(WSP() + WS_WGLU))
#define WSO ((bf16*)(WSP() + WS_WSO))
#define WAO ((bf16*)(WSP() + WS_WAO))
#define WO ((bf16*)(WSP() + WS_WO))
#define WUP ((bf16*)(WSP() + WS_WUP))
#define WDN ((bf16*)(WSP() + WS_WDN))
#define TE ((bf16*)(WSP() + WS_TE))
#define FT ((bf16*)(WSP() + WS_F))
#define CP ((float*)(WSP() + WS_CP))
#define BP ((float*)(WSP() + WS_BP))
#define AT ((float*)(WSP() + WS_AT))
#define XB ((bf16*)(WSP() + WS_XB))
#define MIX ((bf16*)(WSP() + WS_MIX))
#define UM ((bf16*)(WSP() + WS_UM))
#define H1B ((bf16*)(WSP() + WS_H1B))
#define QB ((bf16*)(WSP() + WS_QB))
#define KB ((bf16*)(WSP() + WS_KB))
#define VB ((bf16*)(WSP() + WS_VB))
#define YSS ((bf16*)(WSP() + WS_YSS))
#define PATT ((bf16*)(WSP() + WS_PATT))
#define GSA ((bf16*)(WSP() + WS_GSA))
#define EB ((float*)(WSP() + WS_EB))
#define YATT ((bf16*)(WSP() + WS_YATT))
#define YG ((bf16*)(WSP() + WS_YG))
#define ACT ((bf16*)(WSP() + WS_ACT))
__global__ void __launch_bounds__(NWAVES * 64, 2) hybrid_fwd(Params P) {
    extern __shared__ __attribute__((aligned(16))) unsigned char lds_raw[];
    LAS unsigned char* lds = (LAS unsigned char*)lds_raw;
    const int tid = threadIdx.x, lane = tid & 63, wave = __builtin_amdgcn_readfirstlane(tid >> 6);
    const int G = gridDim.x, bx = blockIdx.x;
    const int vcu = (G % 8 == 0) ? (bx % 8) * (G / 8) + bx / 8 : bx;
    const int gw = bx * NWAVES + wave, NGW = G * NWAVES;
    const int lo = P.ph_lo, hi = P.ph_hi;
    if (tid < 64) ((LAS unsigned*)(lds + LDS_X))[tid] = 0u;
    __syncthreads();
    XcdBarrier xbar = xcd_barrier_post((unsigned*)(WSP() + WS_BAR), (volatile LAS unsigned*)(lds + LDS_X));
#define IN(k) (lo <= (k) && (k) < hi)
#define SEAM(k) do { if (IN(k) && IN((k) + 1)) { if (hi > 1000) cg::this_grid().sync(); else xcd_barrier(xbar); } } while (0)

    if (IN(0)) {
        for (int v = bx; v < NG * 8; v += G) ssm_tables(v >> 3, v & 7, (LAS float*)lds, TE, FT, LAM16);
        LAS float* scr = (LAS float*)(lds + wave * 16384);
        for (int it = gw; it < 16 * 128; it += NGW) tr_item(INP(3), INC, 1024, WIN, 128, 0, INP(2), scr, it, lane);
        for (int i = bx * 512 + tid; i < RP; i += G * 512) SS2[i] = 0.f;
        for (int m0 = gw * 4; m0 < MAINR + NMETA; m0 += NGW * 4) {
            const float* src[4]; bf16* dst[4]; float* rr[4];
#pragma unroll
            for (int r = 0; r < 4; ++r) { const int m = m0 + r; src[r] = m < MAINR ? INP(0) + (size_t)m * 1024 : INP(1) + (size_t)(m - MAINR) * 1024; dst[r] = XB + (size_t)m * 1024; rr[r] = R1 + m; }
            rows_to_bf16<4>(src, dst, rr, lane);
        }
        for (int i = bx * 512 + tid; i < (RP - CROWS) * 512 / 8; i += G * 512) { ((u32x4*)(KB + (size_t)CROWS * 512))[i] = (u32x4){0u, 0u, 0u, 0u}; ((u32x4*)(VB + (size_t)CROWS * 512))[i] = (u32x4){0u, 0u, 0u, 0u}; }
        __syncthreads();
    }
    SEAM(0);
    if (IN(1)) {
        EpiG<FIn> E{FIn{R1, UM, QB, KB, VB, GSA, INP(14), INP(15)}};
        skinny16(XB + (size_t)MAINR * 1024, 1024, WIN, 1024, INC, 1024, bx, G, lane, wave, (LAS float*)lds, E.f);
        pg8::Gemm g{XB, WIN, MAINR, INC, 1024, 1024, 1024}; pg8::StaticOrder S; S.init(MAINR, INC, G, bx);
        pg8::gemm_phase<EpiG<FIn>, pg8::StaticOrder, true, true>(lds, g, S, E);
    }
    SEAM(1);
    if (IN(2)) {
        EpiG<FE> E{FE{EB}};
        skinny_ssm(UM, FT, 256, 256, bx, G, lane, wave, (LAS float*)lds, E.f);
        pg8::Gemm g{UM, FT, NG * NCP, NG * 256, 256, UMK, 256}; SsmOrder S{G, bx};
        pg8::gemm_phase<EpiG<FE>, SsmOrder, true, true>(lds, g, S, E);
    }
    SEAM(2);
    if (IN(3)) {
        const int nscan = G >= 64 ? 32 : G;
        if (bx < nscan) { for (int v = bx * NWAVES + wave; v < NBATCH * NG; v += nscan * NWAVES) ssm_scan(EB, LAM16, UM, v, lane); }
        if (bx >= nscan || nscan == G) {
            LAS float* scr = (LAS float*)(lds + wave * 16384);
            constexpr int I_GLU = 8 * 16, I_SO = 8 * 32, I_AO = 8 * 32, I_WO = 16 * 32, I_UP = 16 * 176, I_DN = 44 * 32;
            constexpr int NITEMS = I_GLU + I_SO + I_AO + I_WO + I_UP + I_DN;
            const int tw0 = nscan == G ? gw : (bx - nscan) * NWAVES + wave, tnw = nscan == G ? NGW : (G - nscan) * NWAVES;
            for (int it = tw0; it < NITEMS; it += tnw) {
                int r = it;
                if (r < I_GLU) { tr_item(INP(12), 512, 512, WGLU, 16, 0, nullptr, scr, r, lane); continue; } r -= I_GLU;
                if (r < I_SO) { tr_item(INP(21), 1024, 512, WSO, 32, 0, nullptr, scr, r, lane); continue; } r -= I_SO;
                if (r < I_AO) { tr_item(INP(22), 1024, 512, WAO, 32, 0, nullptr, scr, r, lane); continue; } r -= I_AO;
                if (r < I_WO) { tr_item(INP(23), 1024, 1024, WO, 32, 0, nullptr, scr, r, lane); continue; } r -= I_WO;
                if (r < I_UP) { tr_item(INP(25), UPC, 1024, WUP, 176, 1, INP(24), scr, r, lane); continue; } r -= I_UP;
                tr_item(INP(28), 1024, DFF, WDN, 32, 0, nullptr, scr, r, lane);
            }
        }
        const float gqm = fabsf(INP(14)[lane]), gkm = fabsf(INP(15)[lane]);
        float gq = gqm, gk = gkm;
#pragma unroll
        for (int o = 1; o < 64; o <<= 1) { gq = fmaxf(gq, __shfl_xor(gq, o)); gk = fmaxf(gk, __shfl_xor(gk, o)); }
        const float Rb = 2.2f * 8.f * gq * gk + 110.f;
        volatile LAS int* qw = (volatile LAS int*)(lds + LDS_X + 512);
        unsigned* qctr = (unsigned*)(WSP() + WS_BAR) + 4000;
        const float lam = __expf(wave_sum(INP(16)[lane] * INP(17)[lane])) - __expf(wave_sum(INP(18)[lane] * INP(19)[lane])) + 0.2f;
        for (;;) {
            if (tid == 0) *qw = (int)atomicAdd(qctr, 1u);
            __syncthreads();
            const int id = *qw;
            __syncthreads();
            if (id >= 1024 + 4) break;
            int b, h, q0, js, nt, D = 8192;
            if (id >= 1024) { b = 0; h = id - 1024; q0 = -112; js = 0; nt = 1; }
            else { const int hb = 31 - (id >> 5), bh = id & 31; b = bh >> 2; h = bh & 3; q0 = 16 + 128 * hb; nt = ((q0 + 127) >> 6) + 1;
                   const float Df = Rb * (float)(4 << (2 * h));
                   D = Df > 8192.f ? 8192 : (int)Df; js = q0 - D > 0 ? (q0 - D) >> 6 : 0; }
            attn_unit(QB, KB, VB, YATT, INP(20), lam, b, h, q0, js, D, nt, lds);
        }
    }
    SEAM(3);
    if (IN(4)) {
        EpiG<FY> E{FY{YG}};
        skinny_ssm(UM, TE, UMK, UMK, bx, G, lane, wave, (LAS float*)lds, E.f);
        pg8::Gemm g{UM, TE, NG * NCP, NG * 256, UMK, UMK, UMK}; SsmOrder S{G, bx};
        pg8::gemm_phase<EpiG<FY>, SsmOrder, true, true>(lds, g, S, E);
    }
    SEAM(4);
    if (IN(5)) {
        EpiG<FGlu> E1{FGlu{YG, YSS, INP(13)}}; EpiG<FPatt> E2{FPatt{GSA, PATT}};
        skinny16(YG + (size_t)MAINR * 512, 512, WGLU, 512, 512, 512, bx, G, lane, wave, (LAS float*)lds, E1.f);
        skinny16(YATT + (size_t)MAINR * 512, 512, WAO, 512, 1024, 512, bx, G, lane, wave, (LAS float*)lds, E2.f, 8);
        { pg8::Gemm g{YG, WGLU, MAINR, 512, 512, 512, 512}; pg8::StaticOrder S; S.init(MAINR, 512, G, bx); pg8::gemm_phase<EpiG<FGlu>, pg8::StaticOrder, true, true>(lds, g, S, E1); }
        { pg8::Gemm g{YATT, WAO, MAINR, 1024, 512, 512, 512}; pg8::StaticOrder S; S.init(MAINR, 1024, G, bx); pg8::gemm_phase<EpiG<FPatt>, pg8::StaticOrder, true, true>(lds, g, S, E2); }
    }
    SEAM(5);
    if (IN(6)) {
        EpiG<FMix> E{FMix{GSA, PATT, MIX}};
        skinny16(YSS + (size_t)MAINR * 512, 512, WSO, 512, 1024, 512, bx, G, lane, wave, (LAS float*)lds, E.f);
        pg8::Gemm g{YSS, WSO, MAINR, 1024, 512, 512, 512}; pg8::StaticOrder S; S.init(MAINR, 1024, G, bx);
        pg8::gemm_phase<EpiG<FMix>, pg8::StaticOrder, true, true>(lds, g, S, E);
    }
    SEAM(6);
    if (IN(7)) {
        EpiG<FWo> E{FWo{XB, H1B, SS2}};
        skinny16(MIX + (size_t)MAINR * 1024, 1024, WO, 1024, 1024, 1024, bx, G, lane, wave, (LAS float*)lds, E.f);
        pg8::Gemm g{MIX, WO, MAINR, 1024, 1024, 1024, 1024}; pg8::StaticOrder S; S.init(MAINR, 1024, G, bx);
        pg8::gemm_phase<EpiG<FWo>, pg8::StaticOrder, true, true>(lds, g, S, E);
    }
    SEAM(7);
    if (IN(8)) {
        FUpMeta fm{SS2, AM};
        skinny16(H1B + (size_t)MAINR * 1024, 1024, WUP, 1024, UPC, 1024, bx, G, lane, wave, (LAS float*)lds, fm);
        EpiUp E{SS2, INP(26), INP(27), ACT, CP, BP, AT, (LAS float*)(lds + LDS_X + 1024)};
        pg8::Gemm g{H1B, WUP, MAINR, UPC, 1024, 1024, 1024}; pg8::StaticOrder S; S.init(MAINR, UPC, G, bx);
        pg8::gemm_phase<EpiUp, pg8::StaticOrder, true, true>(lds, g, S, E);
    }
    do { if (IN(8) && IN(10)) xcd_barrier(xbar); } while (0);
    if (IN(10)) {
        pg8::StaticOrder S; S.init(MAINR, 1024, G, bx);
        {
            const float* cw = INP(26); pg8::Unit uu; int lastpm = -1;
            for (int ui = 0; S.next(ui, uu); ++ui) {
                const int pm = uu.pm; if (pm == lastpm) continue; lastpm = pm;
                for (int i = tid; i < 2 * (DFF / 4); i += 512) {
                    const int q = i % (DFF / 4), row = i / (DFF / 4), pr = pm * 2 + row, hid = 4 * q;
                    const float* a2p = (pm & 15) == 0 ? AM + hid : AT + (size_t)((pm - 1) * 2) * DFF + hid;
                    const f32x4 am2 = *(const f32x4*)a2p, am1 = *(const f32x4*)(a2p + DFF);
                    const f32x4 w0 = *(const f32x4*)(cw + hid), w1 = *(const f32x4*)(cw + DFF + hid);
                    f32x4 c = *(const f32x4*)(CP + (size_t)pr * DFF + hid); const f32x4 bg = *(const f32x4*)(BP + (size_t)pr * DFF + hid);
                    if (row == 0) c += w1 * am1 + w0 * am2; else c += w0 * am1;
                    const f32x4 o = gelu4(c) * bg;
                    u32x2 w; w.x = cvtpk(o[0], o[1]); w.y = cvtpk(o[2], o[3]);
                    *(u32x2*)(ACT + (size_t)(pm * 256 + row) * DFF + hid) = w;
                }
            }
            asm volatile("s_waitcnt vmcnt(0)" ::: "memory"); __syncthreads();
        }
        EpiG<FDown> E{FDown{H1B, OUTP()}};
        pg8::Gemm g{ACT, WDN, MAINR, 1024, DFF, DFF, DFF};
        pg8::gemm_phase<EpiG<FDown>, pg8::StaticOrder, true, true>(lds, g, S, E);
    }
#undef IN
#undef SEAM
}
#undef R1
#undef SS2
#undef H1M
#undef LAM16
#undef AM
#undef WIN
#undef WGLU
#undef WSO
#undef WAO
#undef WO
#undef WUP
#undef WDN
#undef TE
#undef FT
#undef CP
#undef BP
#undef AT
#undef XB
#undef MIX
#undef UM
#undef H1B
#undef QB
#undef KB
#undef VB
#undef YSS
#undef PATT
#undef GSA
#undef EB
#undef YATT
#undef YG
#undef ACT

extern "C" void kernel_launch(void* const* d_in, const int* in_sizes, int n_in, void* d_out, int out_size, void* d_ws, size_t ws_size, hipStream_t stream) {
    static int grid = 0;
    if (grid == 0) {
        if (n_in != 29 || ws_size < WS_END) { fprintf(stderr, "kernel_launch: unexpected n_in %d or ws_size %zu (need %zu)\n", n_in, ws_size, (size_t)WS_END); grid = -1; return; }
        int dev = 0, cus = 0, per_cu = 0;
        (void)hipGetDevice(&dev); (void)hipDeviceGetAttribute(&cus, hipDeviceAttributeMultiprocessorCount, dev);
        if (hipFuncSetAttribute((const void*)hybrid_fwd, hipFuncAttributeMaxDynamicSharedMemorySize, LDS_BYTES) != hipSuccess) { fprintf(stderr, "kernel_launch: hipFuncSetAttribute failed\n"); grid = -1; return; }
        if (hipOccupancyMaxActiveBlocksPerMultiprocessor(&per_cu, (const void*)hybrid_fwd, NWAVES * 64, LDS_BYTES) != hipSuccess || per_cu < 1) { fprintf(stderr, "kernel_launch: occupancy query says %d\n", per_cu); per_cu = 1; }
        (void)hipGetLastError();
        grid = cus * 1;
        if (grid != 256) fprintf(stderr, "kernel_launch: note: %d CUs\n", grid);
    }
    if (grid < 0) return;
    if (hipMemsetAsync((char*)d_ws + WS_BAR, 0, 16384, stream) != hipSuccess) { fprintf(stderr, "kernel_launch: memset failed\n"); return; }
    Params p{};
    for (int i = 0; i < 29; ++i) p.in[i] = (const float*)d_in[i];
    p.out = (float*)d_out; p.ws = (unsigned char*)d_ws;
    p.ph_lo = 0; p.ph_hi = NPHASE;
    void* args[] = {&p};
    hipError_t e = hipLaunchCooperativeKernel((const void*)hybrid_fwd, dim3(grid), dim3(NWAVES * 64), args, LDS_BYTES, stream);
    if (e != hipSuccess) fprintf(stderr, "cooperative launch failed: %s (grid %d)\n", hipGetErrorString(e), grid);
}
```
